# Optimizing an MI355X kernel written in HIP

```python
import math
import jax, jax.numpy as jnp
from jax import lax
import numpy as np

D_MODEL = 2048
BATCH = 1
SEQ = 16384
DEPTH = 2
DEC_BATCH = 2
DEC_SEQ = 8192
PAST_LEN = 128

GRID_W = 64
N_HEADS = 8
HEAD_DIM = 128
ATT_WIDTH = N_HEADS * HEAD_DIM
KH_MAX = 8
KW = 16
F_GROUPS = 4
F_GROUP_DIM = 256
F_WIDTH = F_GROUPS * F_GROUP_DIM
IN_WIDTH = 3 * ATT_WIDTH + F_WIDTH
D_FF = ((8 * D_MODEL + 3 * 256 - 1) // (3 * 256)) * 256
LN_EPS = 1e-5
DEEPNORM_ALPHA = (2.0 * DEPTH) ** 0.25
DEEPNORM_BETA = (8.0 * DEPTH) ** -0.25

kernel_name = "hybrid_natten_fnet_deepnorm_encoder"


def _layer_norm(x, g, b):
    xf = x.astype(jnp.float32)
    mu = jnp.mean(xf, axis=-1, keepdims=True)
    var = jnp.mean(jnp.square(xf - mu), axis=-1, keepdims=True)
    y = (xf - mu) * lax.rsqrt(var + LN_EPS)
    return (y * g.astype(jnp.float32) + b.astype(jnp.float32)).astype(x.dtype)


def _neighbourhood_attention(q, k, v, rpb):
    B, T, H, Dh = q.shape
    rows = T // GRID_W
    kh = min(KH_MAX, rows)
    qg = q.reshape(B, rows, GRID_W, H, Dh)
    kg = k.reshape(B, rows, GRID_W, H, Dh)
    vg = v.reshape(B, rows, GRID_W, H, Dh)
    cols = np.arange(GRID_W)
    col_start = np.clip(cols - KW // 2, 0, GRID_W - KW)
    col_idx = col_start[:, None] + np.arange(KW)[None, :]
    col_bias_idx = col_idx - cols[:, None] + (KW - 1)
    rpb_cols = rpb[:, :, col_bias_idx].astype(jnp.float32)
    scale = HEAD_DIM ** -0.5

    def one_row(r):
        r_start = jnp.clip(r - kh // 2, 0, rows - kh)
        k_rows = lax.dynamic_slice_in_dim(kg, r_start, kh, axis=1)
        v_rows = lax.dynamic_slice_in_dim(vg, r_start, kh, axis=1)
        k_win = k_rows[:, :, col_idx]
        v_win = v_rows[:, :, col_idx]
        row_bias_idx = r_start - r + (KH_MAX - 1) + jnp.arange(kh)
        bias = jnp.take(rpb_cols, row_bias_idx, axis=1)
        bias = jnp.transpose(bias, (0, 2, 1, 3))
        q_row = lax.dynamic_index_in_dim(qg, r, axis=1, keepdims=False)
        s = jnp.einsum('bchd,bicjhd->bhcij', q_row, k_win).astype(jnp.float32)
        s = s * scale + bias[None]
        p = jax.nn.softmax(s.reshape(B, H, GRID_W, kh * KW), axis=-1)
        p = p.reshape(B, H, GRID_W, kh, KW).astype(v.dtype)
        return jnp.einsum('bhcij,bicjhd->bchd', p, v_win)

    out = lax.map(one_row, jnp.arange(rows))
    return jnp.moveaxis(out, 0, 1).reshape(B, T, H * Dh)


def _fourier_mix(u):
    B, T, C = u.shape
    ug = u.reshape(B, T, F_GROUPS, F_GROUP_DIM).astype(jnp.float32)
    mixed = jnp.fft.fft2(ug, axes=(1, 3), norm="ortho").real
    return mixed.reshape(B, T, C).astype(u.dtype)


def _trunk_layer(x, w_in, rpb, w_att, w_four, w_gate, b_gate, w_out, ln1_g, ln1_b,
                 w_ffn_gate, w_ffn_up, w_ffn_down, ln2_g, ln2_b):
    B, T, _ = x.shape
    proj = x @ w_in
    q, k, v, u = jnp.split(proj, [ATT_WIDTH, 2 * ATT_WIDTH, 3 * ATT_WIDTH], axis=-1)
    q = q.reshape(B, T, N_HEADS, HEAD_DIM)
    k = k.reshape(B, T, N_HEADS, HEAD_DIM)
    v = v.reshape(B, T, N_HEADS, HEAD_DIM)
    a = _neighbourhood_attention(q, k, v, rpb) @ w_att
    f = _fourier_mix(u) @ w_four
    gates = jax.nn.sigmoid(x @ w_gate + b_gate)
    g_a, g_f = jnp.split(gates, 2, axis=-1)
    mixed = (g_a * a + g_f * f) @ w_out
    x = _layer_norm(DEEPNORM_ALPHA * x + mixed, ln1_g, ln1_b)
    h = jax.nn.silu(x @ w_ffn_gate) * (x @ w_ffn_up)
    x = _layer_norm(DEEPNORM_ALPHA * x + h @ w_ffn_down, ln2_g, ln2_b)
    return x


def _trunk(x, ln_in_g, ln_in_b, w_in, rpb, w_att, w_four, w_gate, b_gate, w_out,
           ln1_g, ln1_b, w_ffn_gate, w_ffn_up, w_ffn_down, ln2_g, ln2_b):
    x = _layer_norm(x, ln_in_g, ln_in_b)
    for l in range(DEPTH):
        x = _trunk_layer(x, w_in[l], rpb[l], w_att[l], w_four[l], w_gate[l], b_gate[l],
                         w_out[l], ln1_g[l], ln1_b[l], w_ffn_gate[l], w_ffn_up[l],
                         w_ffn_down[l], ln2_g[l], ln2_b[l])
    return x


def setup_inputs(seed: int = 0) -> dict:
    key = jax.random.key(seed)
    ks = jax.random.split(key, 20)
    nrm = jax.random.normal
    f32 = jnp.float32
    return {
        "x_prompt": nrm(ks[0], (BATCH, SEQ, D_MODEL), f32),
        "x_sample": nrm(ks[1], (DEC_BATCH, DEC_SEQ, D_MODEL), f32),
        "ln_in_g": 1.0 + 0.02 * nrm(ks[2], (D_MODEL,), f32),
        "ln_in_b": 0.02 * nrm(ks[3], (D_MODEL,), f32),
        "w_in": nrm(ks[4], (DEPTH, D_MODEL, IN_WIDTH), f32) * D_MODEL ** -0.5,
        "rpb": 0.1 * nrm(ks[5], (DEPTH, N_HEADS, 2 * KH_MAX - 1, 2 * KW - 1), f32),
        "w_att": nrm(ks[6], (DEPTH, ATT_WIDTH, D_MODEL), f32) * ATT_WIDTH ** -0.5,
        "w_four": nrm(ks[7], (DEPTH, F_WIDTH, D_MODEL), f32) * F_WIDTH ** -0.5,
        "w_gate": nrm(ks[8], (DEPTH, D_MODEL, 2 * D_MODEL), f32) * D_MODEL ** -0.5,
        "b_gate": 0.01 * nrm(ks[9], (DEPTH, 2 * D_MODEL), f32),
        "w_out": nrm(ks[10], (DEPTH, D_MODEL, D_MODEL), f32) * (D_MODEL ** -0.5 * DEEPNORM_BETA),
        "ln1_g": 1.0 + 0.02 * nrm(ks[11], (DEPTH, D_MODEL), f32),
        "ln1_b": 0.02 * nrm(ks[12], (DEPTH, D_MODEL), f32),
        "w_ffn_gate": nrm(ks[13], (DEPTH, D_MODEL, D_FF), f32) * D_MODEL ** -0.5,
        "w_ffn_up": nrm(ks[14], (DEPTH, D_MODEL, D_FF), f32) * D_MODEL ** -0.5,
        "w_ffn_down": nrm(ks[15], (DEPTH, D_FF, D_MODEL), f32) * (D_FF ** -0.5 * DEEPNORM_BETA),
        "ln2_g": 1.0 + 0.02 * nrm(ks[16], (DEPTH, D_MODEL), f32),
        "ln2_b": 0.02 * nrm(ks[17], (DEPTH, D_MODEL), f32),
    }


def reference(x_prompt, x_sample, ln_in_g, ln_in_b, w_in, rpb, w_att, w_four, w_gate,
              b_gate, w_out, ln1_g, ln1_b, w_ffn_gate, w_ffn_up, w_ffn_down, ln2_g, ln2_b):
    y_prompt = _trunk(x_prompt, ln_in_g, ln_in_b, w_in, rpb, w_att, w_four, w_gate, b_gate,
                      w_out, ln1_g, ln1_b, w_ffn_gate, w_ffn_up, w_ffn_down, ln2_g, ln2_b)
    y_sample = _trunk(x_sample, ln_in_g, ln_in_b, w_in, rpb, w_att, w_four, w_gate, b_gate,
                      w_out, ln1_g, ln1_b, w_ffn_gate, w_ffn_up, w_ffn_down, ln2_g, ln2_b)
    return (y_prompt, y_sample)
```

```cpp
#include <hip/hip_runtime.h>
#include <hip/hip_cooperative_groups.h>
#include <cstdio>
#include <cstdint>
namespace cg = cooperative_groups;

#define LAS __attribute__((address_space(3)))
typedef unsigned short bf16_t;
typedef short bf16x8 __attribute__((ext_vector_type(8)));
typedef short s16x4 __attribute__((ext_vector_type(4)));
typedef float f32x4 __attribute__((ext_vector_type(4)));
typedef float f32x2 __attribute__((ext_vector_type(2)));
typedef unsigned u32x4 __attribute__((ext_vector_type(4)));
typedef unsigned u32x2 __attribute__((ext_vector_type(2)));

#ifndef MK_PER_PHASE
#define MK_PER_PHASE 0
#endif

constexpr int DM = 2048, TALL = 32768, CHT = 16384, DEPTH = 2, DFF = 5632;
constexpr int B1_LD = 5120, Q_OFF = 0, VR_OFF = 1024, VI_OFF = 2048, K_OFF = 3072, V_OFF = 4096;
constexpr int G_LD = 4096, Z_LD = 2048, MB_LD = 2048, H_LD = 5632;
constexpr float LN_EPS = 1e-5f;
constexpr float ALPHA = 1.41421356237309515f;

constexpr size_t MiB = 1u << 20;
constexpr size_t WS_BT1 = 0, WS_BT3 = 32 * MiB, WS_WFT = 44 * MiB, WS_BT4 = 48 * MiB, WS_BT5 = 56 * MiB, WS_BT6 = 100 * MiB, WS_TAB = 122 * MiB;
constexpr size_t WS_XB = 124 * MiB, WS_R = 252 * MiB, WS_B1 = WS_R, WS_G = WS_R + 160 * MiB, WS_Z = WS_R + 288 * MiB, WS_H = WS_R, WS_CTL = WS_R + 352 * MiB, WS_YB = WS_CTL + 1 * MiB, WS_END = WS_YB + 28 * MiB;
constexpr int LDS_BYTES = 147456;

typedef __bf16 bf16x2_t __attribute__((ext_vector_type(2)));
__device__ __forceinline__ unsigned cvt_pk_bf16(float lo, float hi) { const f32x2 v = {lo, hi}; const bf16x2_t b = __builtin_convertvector(v, bf16x2_t); return __builtin_bit_cast(unsigned, b); }
__device__ __forceinline__ float bf_lo(unsigned w) { return __uint_as_float(w << 16); }
__device__ __forceinline__ float bf_hi(unsigned w) { return __uint_as_float(w & 0xffff0000u); }
__device__ __forceinline__ float rcpf_(float x) { return __builtin_amdgcn_rcpf(x); }
__device__ __forceinline__ float sigmoidf_(float x) { return rcpf_(1.0f + __builtin_amdgcn_exp2f(x * -1.4426950408889634f)); }

namespace pg8 {
constexpr int BM = 256, BK = 64, HALF = 128, HTB = HALF * BK * 2, STAGE_BYTES = 8 * HTB, NXCD = 8, WGM = 8;
__host__ __device__ __forceinline__ int lds_byte(int r, int c) { const int st = (r >> 4) * 2 + (c >> 5), rr = r & 15, cc = c & 31, ob = rr * 64 + cc * 2; return st * 1024 + (ob ^ (((ob >> 9) & 1) << 5)); }
__host__ __device__ __forceinline__ void stage_rc(int b, int& R, int& C) { const int st = b / 1024, sb = b % 1024, swz = sb ^ (((sb >> 9) & 1) << 5); R = (st >> 1) * 16 + swz / 64; C = (st & 1) * 32 + (swz % 64) / 2; }
__host__ __device__ __forceinline__ int perm32(int rho) { const int n = rho >> 4, i = rho & 15; return 8 * (i >> 2) + 4 * n + (i & 3); }

struct Unit { int pm, pn; };
struct Gemm { const bf16_t* A; const bf16_t* Bt; int lda, ldb, K; };

struct StaticOrder {
    int nM, nN, nwg, G, c;
    __host__ __device__ void init(int M, int N, int G_, int c_) { nM = M / BM; nN = N / BM; nwg = nM * nN; G = G_; c = c_; }
    __host__ __device__ bool next(int i, Unit& u) const {
        const long L = (long)i * G + c; if (L >= nwg) return false;
        int wgid = (int)L; { const int q = nwg / NXCD, r = nwg % NXCD, xcd = wgid % NXCD, off = wgid / NXCD; wgid = (xcd < r ? xcd * (q + 1) : r * (q + 1) + (xcd - r) * q) + off; }
        const int nig = WGM * nN, gid = wgid / nig, fm = gid * WGM, gsz = (nM - fm) < WGM ? (nM - fm) : WGM;
        u.pm = fm + ((wgid % nig) % gsz); u.pn = (wgid % nig) / gsz; return true;
    }
};

typedef f32x4 Acc[2][2][4][2];

struct EpiP1 {
    static constexpr bool PERM = true; static constexpr int MID_T = -1;
    bf16_t* B1; bf16_t* G; const float* bgate;
    __device__ __forceinline__ void mid(Acc&, const Unit&, int, int, int, int) const {}
    __device__ __forceinline__ void operator()(const Acc& acc, const Unit& u, int wr, int wc, int fr, int fq) const {
        const int row0 = u.pm * BM + wr * 64 + fr; const int ct = u.pn;
        if (ct < 16) {
            const int seg = ct >> 2;
            const int coff = (seg == 0 ? Q_OFF : seg == 1 ? K_OFF : seg == 2 ? V_OFF : VR_OFF) + (ct & 3) * 256 + wc * 32 + 8 * fq;
#pragma unroll
            for (int ai = 0; ai < 2; ++ai)
#pragma unroll
                for (int m = 0; m < 4; ++m) { bf16_t* rowp = B1 + (size_t)(row0 + ai * HALF + m * 16) * B1_LD + coff;
#pragma unroll
                    for (int bj = 0; bj < 2; ++bj) { const f32x4 v0 = acc[ai][bj][m][0], v1 = acc[ai][bj][m][1];
                        u32x4 w; w.x = cvt_pk_bf16(v0[0], v0[1]); w.y = cvt_pk_bf16(v0[2], v0[3]); w.z = cvt_pk_bf16(v1[0], v1[1]); w.w = cvt_pk_bf16(v1[2], v1[3]);
                        *(u32x4*)(rowp + bj * HALF) = w; } }
        } else {
            const int gcol0 = (ct - 16) * HALF + wc * 32 + 8 * fq;
            f32x4 ba[2], bf[2];
#pragma unroll
            for (int n = 0; n < 2; ++n) { ba[n] = *(const f32x4*)(bgate + gcol0 + 4 * n); bf[n] = *(const f32x4*)(bgate + DM + gcol0 + 4 * n); }
#pragma unroll
            for (int ai = 0; ai < 2; ++ai)
#pragma unroll
                for (int m = 0; m < 4; ++m) { bf16_t* rowp = G + (size_t)(row0 + ai * HALF + m * 16) * G_LD + gcol0;
                    f32x4 rr[2], gg[2];
#pragma unroll
                    for (int n = 0; n < 2; ++n) { const f32x4 va = acc[ai][0][m][n] + ba[n], vf = acc[ai][1][m][n] + bf[n];
#pragma unroll
                        for (int j = 0; j < 4; ++j) { const float ea = __builtin_amdgcn_exp2f(va[j] * -1.4426950408889634f), ef = __builtin_amdgcn_exp2f(vf[j] * -1.4426950408889634f);
                            gg[n][j] = rcpf_(1.0f + ef); rr[n][j] = (1.0f + ef) * rcpf_(1.0f + ea); } }
                    u32x4 w; w.x = cvt_pk_bf16(rr[0][0], rr[0][1]); w.y = cvt_pk_bf16(rr[0][2], rr[0][3]); w.z = cvt_pk_bf16(rr[1][0], rr[1][1]); w.w = cvt_pk_bf16(rr[1][2], rr[1][3]);
                    *(u32x4*)rowp = w;
                    u32x4 v; v.x = cvt_pk_bf16(gg[0][0], gg[0][1]); v.y = cvt_pk_bf16(gg[0][2], gg[0][3]); v.z = cvt_pk_bf16(gg[1][0], gg[1][1]); v.w = cvt_pk_bf16(gg[1][2], gg[1][3]);
                    *(u32x4*)(rowp + DM) = v; }
        }
    }
};

struct EpiP3 {
    static constexpr bool PERM = true; static constexpr int MID_T = 16;
    const bf16_t* __restrict__ G; bf16_t* __restrict__ Mb;
    __device__ __forceinline__ void mid(Acc& acc, const Unit& u, int wr, int wc, int fr, int fq) const {
        asm volatile("" : "+v"(fr), "+v"(fq));
        const int row0 = u.pm * BM + wr * 64 + fr, col0 = u.pn * BM + wc * 32 + 8 * fq;
#pragma unroll
        for (int ai = 0; ai < 2; ++ai) {
            u32x4 rr[4][2];
#pragma unroll
            for (int m = 0; m < 4; ++m)
#pragma unroll
                for (int bj = 0; bj < 2; ++bj) rr[m][bj] = *(const u32x4*)(G + (size_t)(row0 + ai * HALF + m * 16) * G_LD + col0 + bj * HALF);
#pragma unroll
            for (int m = 0; m < 4; ++m)
#pragma unroll
                for (int bj = 0; bj < 2; ++bj) { const u32x4 a = rr[m][bj]; f32x4 r0, r1;
                    r0[0] = bf_lo(a.x); r0[1] = bf_hi(a.x); r0[2] = bf_lo(a.y); r0[3] = bf_hi(a.y); r1[0] = bf_lo(a.z); r1[1] = bf_hi(a.z); r1[2] = bf_lo(a.w); r1[3] = bf_hi(a.w);
                    acc[ai][bj][m][0] *= r0; acc[ai][bj][m][1] *= r1; }
            asm volatile("" ::: "memory"); }
    }
    __device__ __forceinline__ void operator()(const Acc& acc, const Unit& u, int wr, int wc, int fr, int fq) const {
        const int row0 = u.pm * BM + wr * 64 + fr, col0 = u.pn * BM + wc * 32 + 8 * fq;
#pragma unroll
        for (int ai = 0; ai < 2; ++ai) {
            u32x4 gf[4][2];
#pragma unroll
            for (int m = 0; m < 4; ++m)
#pragma unroll
                for (int bj = 0; bj < 2; ++bj) gf[m][bj] = *(const u32x4*)(G + (size_t)(row0 + ai * HALF + m * 16) * G_LD + DM + col0 + bj * HALF);
#pragma unroll
            for (int m = 0; m < 4; ++m)
#pragma unroll
                for (int bj = 0; bj < 2; ++bj) { const u32x4 f = gf[m][bj]; const f32x4 v0 = acc[ai][bj][m][0], v1 = acc[ai][bj][m][1];
                    u32x4 w; w.x = cvt_pk_bf16(v0[0] * bf_lo(f.x), v0[1] * bf_hi(f.x)); w.y = cvt_pk_bf16(v0[2] * bf_lo(f.y), v0[3] * bf_hi(f.y));
                    w.z = cvt_pk_bf16(v1[0] * bf_lo(f.z), v1[1] * bf_hi(f.z)); w.w = cvt_pk_bf16(v1[2] * bf_lo(f.w), v1[3] * bf_hi(f.w));
                    *(u32x4*)(Mb + (size_t)(row0 + ai * HALF + m * 16) * MB_LD + col0 + bj * HALF) = w; }
            asm volatile("" ::: "memory"); }
    }
};

struct EpiY {
    static constexpr bool PERM = true; static constexpr int MID_T = -1;
    bf16_t* Y; bf16_t* Y2; int split;
    __device__ __forceinline__ void mid(Acc&, const Unit&, int, int, int, int) const {}
    __device__ __forceinline__ void operator()(const Acc& acc, const Unit& u, int wr, int wc, int fr, int fq) const {
        const int row0 = u.pm * BM + wr * 64 + fr, col0 = u.pn * BM + wc * 32 + 8 * fq;
        bf16_t* Yb = (u.pm < split) ? Y : Y2;
#pragma unroll
        for (int ai = 0; ai < 2; ++ai)
#pragma unroll
            for (int m = 0; m < 4; ++m) { bf16_t* rowp = Yb + (size_t)(row0 + ai * HALF + m * 16) * DM + col0;
#pragma unroll
                for (int bj = 0; bj < 2; ++bj) { const f32x4 v0 = acc[ai][bj][m][0], v1 = acc[ai][bj][m][1];
                    u32x4 w; w.x = cvt_pk_bf16(v0[0], v0[1]); w.y = cvt_pk_bf16(v0[2], v0[3]); w.z = cvt_pk_bf16(v1[0], v1[1]); w.w = cvt_pk_bf16(v1[2], v1[3]);
                    *(u32x4*)(rowp + bj * HALF) = w; } }
    }
};

struct EpiSwiglu {
    static constexpr bool PERM = true; static constexpr int MID_T = -1;
    bf16_t* H;
    __device__ __forceinline__ void mid(Acc&, const Unit&, int, int, int, int) const {}
    __device__ __forceinline__ void operator()(const Acc& acc, const Unit& u, int wr, int wc, int fr, int fq) const {
        const int row0 = u.pm * BM + wr * 64 + fr, col0 = u.pn * HALF + wc * 32 + 8 * fq;
#pragma unroll
        for (int ai = 0; ai < 2; ++ai)
#pragma unroll
            for (int m = 0; m < 4; ++m) { bf16_t* rowp = H + (size_t)(row0 + ai * HALF + m * 16) * H_LD + col0;
                f32x4 o0, o1;
#pragma unroll
                for (int j = 0; j < 4; ++j) { const float g0 = acc[ai][0][m][0][j], g1 = acc[ai][0][m][1][j];
                    o0[j] = g0 * sigmoidf_(g0) * acc[ai][1][m][0][j]; o1[j] = g1 * sigmoidf_(g1) * acc[ai][1][m][1][j]; }
                u32x4 w; w.x = cvt_pk_bf16(o0[0], o0[1]); w.y = cvt_pk_bf16(o0[2], o0[3]); w.z = cvt_pk_bf16(o1[0], o1[1]); w.w = cvt_pk_bf16(o1[2], o1[3]);
                *(u32x4*)rowp = w; }
    }
};

struct EpiFold {
    static constexpr bool PERM = true; static constexpr int MID_T = -1;
    bf16_t* Bt3;
    __device__ __forceinline__ void mid(Acc&, const Unit&, int, int, int, int) const {}
    __device__ __forceinline__ void operator()(const Acc& acc, const Unit& u, int wr, int wc, int fr, int fq) const {
        const int g = u.pm >> 3, d0 = (u.pm & 7) * 256 + wr * 64 + fr, col0 = 1024 + u.pn * 1024 + g * 256 + wc * 32 + 8 * fq;
#pragma unroll
        for (int ai = 0; ai < 2; ++ai)
#pragma unroll
            for (int m = 0; m < 4; ++m) { bf16_t* rowp = Bt3 + (size_t)(d0 + ai * HALF + m * 16) * 3072 + col0;
#pragma unroll
                for (int bj = 0; bj < 2; ++bj) { const f32x4 v0 = acc[ai][bj][m][0], v1 = acc[ai][bj][m][1];
                    u32x4 w; w.x = cvt_pk_bf16(v0[0], v0[1]); w.y = cvt_pk_bf16(v0[2], v0[3]); w.z = cvt_pk_bf16(v1[0], v1[1]); w.w = cvt_pk_bf16(v1[2], v1[3]);
                    *(u32x4*)(rowp + bj * HALF) = w; } }
    }
};

template <class Epi, bool ALIGN_EPI = true>
__device__ __forceinline__ void gemm_phase(LAS unsigned char* lds, const Gemm g, const StaticOrder& S, const Epi& E, const int tid) {
    const int wid = __builtin_amdgcn_readfirstlane(tid >> 6), lane = tid & 63, wr = wid >> 2, wc = wid & 3, fr = lane & 15, fq = lane >> 4;
    const int K = g.K; int nt = K / BK; asm volatile("" : "+s"(nt));
    unsigned voffA[2], voffB[2];
#pragma unroll
    for (int i = 0; i < 2; ++i) { int R, C; stage_rc(tid * 16 + i * 8192, R, C); const int Rb = Epi::PERM ? ((R & ~31) + perm32(R & 31)) : R;
        voffA[i] = (unsigned)(R * g.lda + C) * 2u; voffB[i] = (unsigned)(Rb * g.ldb + C) * 2u; }
    const size_t kstep = (size_t)(BK * 2);
    const size_t hA = (size_t)HALF * g.lda * 2, hB = (size_t)HALF * g.ldb * 2;
    const size_t tA = 2 * hA, tB = 2 * hB;
    const unsigned ldsw = (unsigned)wid * 1024u;
    const int aoff = lds_byte(wr * 64 + fr, fq * 8), boff = lds_byte(wc * 32 + fr, fq * 8);
#define PG8_SA(b, h) (((b) * 2 + (h)) * HTB)
#define PG8_SB(b, h) ((4 + (b) * 2 + (h)) * HTB)
#define PG8_STAGE(bufoff, gbase, voff) do { _Pragma("unroll") for (int _i = 0; _i < 2; ++_i) \
        __builtin_amdgcn_global_load_lds((const unsigned*)((const char*)(gbase) + (voff)[_i]), (LAS unsigned*)(lds + (bufoff) + ldsw + _i * 8192), 16, 0, 0); } while (0)
#define PG8_LDA(dst, b, h) do { _Pragma("unroll") for (int m = 0; m < 4; ++m) _Pragma("unroll") for (int k = 0; k < 2; ++k) dst[m][k] = *(const LAS bf16x8*)(lds + PG8_SA(b, h) + aoff + m * 2048 + k * 1024); } while (0)
#define PG8_LDB(dst, b, h) do { _Pragma("unroll") for (int n = 0; n < 2; ++n) _Pragma("unroll") for (int k = 0; k < 2; ++k) dst[n][k] = *(const LAS bf16x8*)(lds + PG8_SB(b, h) + boff + n * 2048 + k * 1024); } while (0)
#define PG8_MMA(ai, bj, At, Bt) do { __builtin_amdgcn_s_setprio(1); _Pragma("unroll") for (int m = 0; m < 4; ++m) _Pragma("unroll") for (int n = 0; n < 2; ++n) _Pragma("unroll") for (int k = 0; k < 2; ++k) \
        acc[ai][bj][m][n] = __builtin_amdgcn_mfma_f32_16x16x32_bf16(Bt[n][k], At[m][k], acc[ai][bj][m][n], 0, 0, 0); __builtin_amdgcn_s_setprio(0); } while (0)
#define PG8_WAIT_V(n) asm volatile("s_waitcnt vmcnt(" #n ")" ::: "memory")
#define PG8_WAIT_L(n) asm volatile("s_waitcnt lgkmcnt(" #n ")" ::: "memory")
#define PG8_BAR __builtin_amdgcn_s_barrier()
#define PG8_SCHED __builtin_amdgcn_sched_barrier(0)
    Unit cur, nxt; int ui = 0;
    if (!S.next(0, cur)) return;
    Acc acc;
#pragma unroll
    for (int a = 0; a < 2; ++a)
#pragma unroll
        for (int b = 0; b < 2; ++b)
#pragma unroll
            for (int m = 0; m < 4; ++m)
#pragma unroll
                for (int n = 0; n < 2; ++n) acc[a][b][m][n] = (f32x4){0.f, 0.f, 0.f, 0.f};
    bf16x8 At[4][2], B0[2][2], B1[2][2];
    const char* cA = (const char*)g.A + (size_t)cur.pm * tA; const char* cB = (const char*)g.Bt + (size_t)cur.pn * tB;
    PG8_STAGE(PG8_SB(0, 0), cB, voffB); PG8_STAGE(PG8_SB(0, 1), cB + hB, voffB); PG8_STAGE(PG8_SA(0, 0), cA, voffA); PG8_STAGE(PG8_SA(0, 1), cA + hA, voffA);
    if (wr == 1) PG8_BAR;
    PG8_WAIT_V(2); PG8_BAR;
    PG8_STAGE(PG8_SB(1, 0), cB + kstep, voffB); PG8_STAGE(PG8_SA(1, 0), cA + kstep, voffA); PG8_STAGE(PG8_SB(1, 1), cB + hB + kstep, voffB);
    PG8_WAIT_V(6); PG8_BAR;
    for (;;) {
        const bool has_next = S.next(ui + 1, nxt);
        const char* nA = has_next ? (const char*)g.A + (size_t)nxt.pm * tA : cA; const char* nB = has_next ? (const char*)g.Bt + (size_t)nxt.pn * tB : cB;
        for (int t = 0; t < nt; t += 2) {
            const bool last = (t == nt - 2);
            const char* a1 = cA + (size_t)(t + 1) * kstep;
            const char* a2 = last ? nA : cA + (size_t)(t + 2) * kstep; const char* b2 = last ? nB : cB + (size_t)(t + 2) * kstep;
            const char* a3 = a2 + kstep; const char* b3 = b2 + kstep;
            if constexpr (Epi::MID_T >= 0) { if (t == Epi::MID_T) { E.mid(acc, cur, wr, wc, fr, fq); PG8_SCHED; } }
            PG8_LDB(B0, 0, 0); PG8_LDB(B1, 0, 1); PG8_SCHED; PG8_LDA(At, 0, 0); PG8_STAGE(PG8_SA(1, 1), a1 + hA, voffA);
            PG8_WAIT_V(8); PG8_WAIT_L(0); PG8_BAR; PG8_MMA(0, 0, At, B0); PG8_MMA(0, 1, At, B1); PG8_BAR; PG8_SCHED;
            PG8_LDA(At, 0, 1); PG8_STAGE(PG8_SB(0, 0), b2, voffB); PG8_STAGE(PG8_SB(0, 1), b2 + hB, voffB); PG8_STAGE(PG8_SA(0, 0), a2, voffA);
            PG8_WAIT_V(8); PG8_WAIT_L(0); PG8_BAR; PG8_MMA(1, 0, At, B0); PG8_MMA(1, 1, At, B1); PG8_BAR; PG8_SCHED;
            PG8_LDB(B0, 1, 0); PG8_LDB(B1, 1, 1); PG8_SCHED; PG8_LDA(At, 1, 0); PG8_STAGE(PG8_SA(0, 1), a2 + hA, voffA);
            PG8_WAIT_V(8); PG8_WAIT_L(0); PG8_BAR; PG8_MMA(0, 0, At, B0); PG8_MMA(0, 1, At, B1); PG8_BAR; PG8_SCHED;
            PG8_LDA(At, 1, 1); PG8_STAGE(PG8_SB(1, 0), b3, voffB); PG8_STAGE(PG8_SB(1, 1), b3 + hB, voffB); PG8_STAGE(PG8_SA(1, 0), a3, voffA);
            PG8_WAIT_V(8); PG8_WAIT_L(0); PG8_BAR; PG8_MMA(1, 0, At, B0); PG8_MMA(1, 1, At, B1); PG8_BAR; PG8_SCHED;
        }
        if constexpr (ALIGN_EPI) { if (wr == 0) PG8_BAR; }
        E(acc, cur, wr, wc, fr, fq);
        if (!has_next) break;
#pragma unroll
        for (int a = 0; a < 2; ++a)
#pragma unroll
            for (int b = 0; b < 2; ++b)
#pragma unroll
                for (int m = 0; m < 4; ++m)
#pragma unroll
                    for (int n = 0; n < 2; ++n) acc[a][b][m][n] = (f32x4){0.f, 0.f, 0.f, 0.f};
        cur = nxt; cA = nA; cB = nB; ++ui;
        if constexpr (ALIGN_EPI) { if (wr == 1) PG8_BAR; }
    }
    PG8_WAIT_V(0);
    if constexpr (!ALIGN_EPI) { if (wr == 0) PG8_BAR; }
    PG8_BAR;
#undef PG8_SA
#undef PG8_SB
#undef PG8_STAGE
#undef PG8_LDA
#undef PG8_LDB
#undef PG8_MMA
#undef PG8_WAIT_V
#undef PG8_WAIT_L
#undef PG8_BAR
#undef PG8_SCHED
}
}

#define LDS_WAIT() asm volatile("s_waitcnt lgkmcnt(0)" ::: "memory")
__device__ __forceinline__ float wave_sum(float v) {
#pragma unroll
    for (int o = 1; o < 64; o <<= 1) v += __shfl_xor(v, o);
    return v;
}
__device__ __forceinline__ s16x4 vtr(const LAS unsigned char* p) { return __builtin_bit_cast(s16x4, __builtin_amdgcn_ds_read_tr16_b64_v4i16((LAS s16x4*)p)); }
__device__ __forceinline__ bf16x8 cat8(s16x4 a, s16x4 b) { bf16x8 r; r[0] = a[0]; r[1] = a[1]; r[2] = a[2]; r[3] = a[3]; r[4] = b[0]; r[5] = b[1]; r[6] = b[2]; r[7] = b[3]; return r; }
__device__ __forceinline__ int swz16(int row) { return ((row & 3) << 2) | ((row >> 2) & 3); }

struct Args {
    const float* in[18]; float* out; unsigned char* ws; int ph_lo, ph_hi;
};

__device__ __forceinline__ void transpose_item(const float* __restrict__ W, int ldw, int k0, int n0, bf16_t* WT, int ldo, int drow0, int dcol0, LAS float* scr, int lane) {
    float t32[32];
#pragma unroll
    for (int i = 0; i < 32; ++i) { const int kk = 2 * i + (lane >> 5); t32[i] = W[(size_t)(k0 + kk) * ldw + n0 + (lane & 31)]; }
#pragma unroll
    for (int i = 0; i < 32; ++i) { const int kk = 2 * i + (lane >> 5); scr[kk * 33 + (lane & 31)] = t32[i]; }
    LDS_WAIT(); asm volatile("" ::: "memory");
    const int c = lane & 7;
#pragma unroll
    for (int j = 0; j < 4; ++j) { const int n = (lane >> 3) + 8 * j; const LAS float* s = scr + (8 * c) * 33 + n;
        u32x4 o; o.x = cvt_pk_bf16(s[0 * 33], s[1 * 33]); o.y = cvt_pk_bf16(s[2 * 33], s[3 * 33]); o.z = cvt_pk_bf16(s[4 * 33], s[5 * 33]); o.w = cvt_pk_bf16(s[6 * 33], s[7 * 33]);
        *(u32x4*)(WT + (size_t)(drow0 + n) * ldo + dcol0 + 8 * c) = o; }
    LDS_WAIT(); asm volatile("" ::: "memory");
}

__device__ __forceinline__ void wphase(const Args& a, int layer, LAS unsigned char* lds, int gw, int NGW, int wave, int lane) {
    unsigned char* ws = a.ws;
    bf16_t* Bt1 = (bf16_t*)(ws + WS_BT1); bf16_t* Bt3 = (bf16_t*)(ws + WS_BT3); bf16_t* WfT = (bf16_t*)(ws + WS_WFT); bf16_t* Bt4 = (bf16_t*)(ws + WS_BT4);
    bf16_t* Bt5 = (bf16_t*)(ws + WS_BT5); bf16_t* Bt6 = (bf16_t*)(ws + WS_BT6); bf16_t* Tab = (bf16_t*)(ws + WS_TAB);
    const float* w_in = a.in[4] + (size_t)layer * DM * 4096; const float* w_att = a.in[6] + (size_t)layer * 1024 * DM; const float* w_four = a.in[7] + (size_t)layer * 1024 * DM;
    const float* w_gate = a.in[8] + (size_t)layer * DM * 4096; const float* w_out = a.in[10] + (size_t)layer * DM * DM;
    const float* w_fg = a.in[13] + (size_t)layer * DM * DFF; const float* w_fu = a.in[14] + (size_t)layer * DM * DFF; const float* w_fd = a.in[15] + (size_t)layer * DFF * DM;
    LAS float* scr = (LAS float*)(lds + wave * 16384);
    constexpr int I_IN = 32 * 128, I_ATT = 16 * 64, I_OUT = 32 * 64, I_FF = 32 * 176, I_FD = 88 * 64;
    constexpr int NITEMS = 2 * I_IN + 2 * I_ATT + I_OUT + 2 * I_FF + I_FD;
    for (int it = gw; it < NITEMS; it += NGW) {
        int r = it;
        if (r < I_IN) { const int kb = r / 128, nb = r % 128; transpose_item(w_in, 4096, 64 * kb, 32 * nb, Bt1, DM, 32 * nb, 64 * kb, scr, lane); continue; } r -= I_IN;
        if (r < I_IN) { const int kb = r / 128, nb = r % 128; const int n0 = 32 * nb, jj = n0 & 2047; transpose_item(w_gate, 4096, 64 * kb, n0, Bt1, DM, 4096 + 256 * (jj >> 7) + 128 * (n0 >> 11) + (jj & 127), 64 * kb, scr, lane); continue; } r -= I_IN;
        if (r < I_ATT) { const int kb = r / 64, nb = r % 64; transpose_item(w_att, DM, 64 * kb, 32 * nb, Bt3, 3072, 32 * nb, 64 * kb, scr, lane); continue; } r -= I_ATT;
        if (r < I_ATT) { const int kb = r / 64, nb = r % 64; const int k0 = 64 * kb; transpose_item(w_four, DM, k0, 32 * nb, WfT, 256, (k0 >> 8) * 2048 + 32 * nb, k0 & 255, scr, lane); continue; } r -= I_ATT;
        if (r < I_OUT) { const int kb = r / 64, nb = r % 64; transpose_item(w_out, DM, 64 * kb, 32 * nb, Bt4, DM, 32 * nb, 64 * kb, scr, lane); continue; } r -= I_OUT;
        if (r < I_FF) { const int kb = r / 176, nb = r % 176; const int n0 = 32 * nb; transpose_item(w_fg, DFF, 64 * kb, n0, Bt5, DM, 256 * (n0 >> 7) + (n0 & 127), 64 * kb, scr, lane); continue; } r -= I_FF;
        if (r < I_FF) { const int kb = r / 176, nb = r % 176; const int n0 = 32 * nb; transpose_item(w_fu, DFF, 64 * kb, n0, Bt5, DM, 256 * (n0 >> 7) + 128 + (n0 & 127), 64 * kb, scr, lane); continue; } r -= I_FF;
        { const int kb = r / 64, nb = r % 64; transpose_item(w_fd, DM, 64 * kb, 32 * nb, Bt6, DFF, 32 * nb, 64 * kb, scr, lane); }
    }
    for (int e = gw * 64 + lane; e < 512 * 256; e += NGW * 64) { const int kc = e & 255, c = (e >> 8) & 255, cs = e >> 16;
        float sv, cv; sincospif((float)((c * kc) & 255) * (1.0f / 128.0f), &sv, &cv); const float v = (cs ? sv : cv) * 0.0625f;
        Tab[e] = (bf16_t)(cvt_pk_bf16(v, 0.f) & 0xffffu); }
}

__device__ __forceinline__ void unpack8(const u32x4 w, float* v) { v[0] = bf_lo(w.x); v[1] = bf_hi(w.x); v[2] = bf_lo(w.y); v[3] = bf_hi(w.y); v[4] = bf_lo(w.z); v[5] = bf_hi(w.z); v[6] = bf_lo(w.w); v[7] = bf_hi(w.w); }
__device__ __forceinline__ void ln_core(float (&v)[4][8], const float* __restrict__ gam, const float* __restrict__ bet, int lane) {
    float s = 0.f;
#pragma unroll
    for (int j = 0; j < 4; ++j)
#pragma unroll
        for (int e = 0; e < 8; ++e) s += v[j][e];
    const float mean = wave_sum(s) * (1.f / DM); float s2 = 0.f;
#pragma unroll
    for (int j = 0; j < 4; ++j)
#pragma unroll
        for (int e = 0; e < 8; ++e) { v[j][e] -= mean; s2 += v[j][e] * v[j][e]; }
    const float rstd = 1.f / sqrtf(wave_sum(s2) * (1.f / DM) + LN_EPS);
#pragma unroll
    for (int j = 0; j < 4; ++j) { const f32x4 g0 = ((const f32x4*)gam)[2 * (lane + 64 * j)], g1 = ((const f32x4*)gam)[2 * (lane + 64 * j) + 1];
        const f32x4 b0 = ((const f32x4*)bet)[2 * (lane + 64 * j)], b1 = ((const f32x4*)bet)[2 * (lane + 64 * j) + 1];
#pragma unroll
        for (int e = 0; e < 4; ++e) { v[j][e] = v[j][e] * rstd * g0[e] + b0[e]; v[j][4 + e] = v[j][4 + e] * rstd * g1[e] + b1[e]; } }
}
__device__ __forceinline__ u32x4 pack8(const float* v) { u32x4 w; w.x = cvt_pk_bf16(v[0], v[1]); w.y = cvt_pk_bf16(v[2], v[3]); w.z = cvt_pk_bf16(v[4], v[5]); w.w = cvt_pk_bf16(v[6], v[7]); return w; }
__device__ __forceinline__ void ln_in_row(const float* src, bf16_t* dstb, const float* __restrict__ gam, const float* __restrict__ bet, int lane) {
    float v[4][8];
#pragma unroll
    for (int j = 0; j < 4; ++j) { const f32x4 a0 = ((const f32x4*)src)[2 * (lane + 64 * j)], a1 = ((const f32x4*)src)[2 * (lane + 64 * j) + 1];
#pragma unroll
        for (int e = 0; e < 4; ++e) { v[j][e] = a0[e]; v[j][4 + e] = a1[e]; } }
    ln_core(v, gam, bet, lane);
#pragma unroll
    for (int j = 0; j < 4; ++j) ((u32x4*)dstb)[lane + 64 * j] = pack8(v[j]);
}
__device__ __forceinline__ void ln_res16_row(bf16_t* xrow, const bf16_t* yrow, const float* __restrict__ gam, const float* __restrict__ bet, int lane) {
    float v[4][8]; u32x4 xw[4], yw[4];
#pragma unroll
    for (int j = 0; j < 4; ++j) { xw[j] = ((const u32x4*)xrow)[lane + 64 * j]; yw[j] = ((const u32x4*)yrow)[lane + 64 * j]; }
#pragma unroll
    for (int j = 0; j < 4; ++j) { float xv[8], yv[8]; unpack8(xw[j], xv); unpack8(yw[j], yv);
#pragma unroll
        for (int e = 0; e < 8; ++e) v[j][e] = xv[e] * ALPHA + yv[e]; }
    ln_core(v, gam, bet, lane);
#pragma unroll
    for (int j = 0; j < 4; ++j) ((u32x4*)xrow)[lane + 64 * j] = pack8(v[j]);
}
__device__ __forceinline__ void ln_res_final16_row(const bf16_t* xrow, const bf16_t* yrow, float* orow, const float* __restrict__ gam, const float* __restrict__ bet, int lane) {
    float v[4][8]; u32x4 xw[4], yw[4];
#pragma unroll
    for (int j = 0; j < 4; ++j) { xw[j] = ((const u32x4*)xrow)[lane + 64 * j]; yw[j] = ((const u32x4*)yrow)[lane + 64 * j]; }
#pragma unroll
    for (int j = 0; j < 4; ++j) { float xv[8], yv[8]; unpack8(xw[j], xv); unpack8(yw[j], yv);
#pragma unroll
        for (int e = 0; e < 8; ++e) v[j][e] = xv[e] * ALPHA + yv[e]; }
    ln_core(v, gam, bet, lane);
#pragma unroll
    for (int j = 0; j < 4; ++j) { f32x4 o0, o1;
#pragma unroll
        for (int e = 0; e < 4; ++e) { o0[e] = v[j][e]; o1[e] = v[j][4 + e]; }
        ((f32x4*)orow)[2 * (lane + 64 * j)] = o0; ((f32x4*)orow)[2 * (lane + 64 * j) + 1] = o1; }
}

__device__ __forceinline__ void attn_phase(LAS unsigned char* lds, bf16_t* B1, const float* __restrict__ rpb, int chunk, int vcu, int G, int tid, int ooff) {
    const int wave = __builtin_amdgcn_readfirstlane(tid >> 6), lane = tid & 63, l15 = lane & 15, g = lane >> 4;
    const int hsel = wave >> 2, cgp = wave & 3;
    const int rows = chunk ? 128 : 256;
    const int nunits = 1024, per = (nunits + G - 1) / G;
    const int sp = (cgp == 0) ? 0 : (cgp == 1) ? 8 : (cgp == 2) ? 24 : 32;
    const int c = 16 * cgp + l15; const int cs = min(max(c - 8, 0), 48);
    const float scale = 0.08838834764831845f;
    LAS float* btab = (LAS float*)(lds + 131072);
    for (int i = tid; i < 8 * 465; i += 512) btab[i] = rpb[i];
    __syncthreads();
    for (int ui = 0; ui < per; ++ui) {
        const int unit = vcu * per + ui; if (unit >= nunits) break;
        const int hp = unit & 3, rowid = unit >> 2, seq = rowid / rows, r = rowid % rows;
        const int h = 2 * hp + hsel;
        const int rs = min(max(r - 4, 0), rows - 8);
        const size_t seqbase = (size_t)seq * rows * 64;
        const bf16_t* qp = B1 + (seqbase + (size_t)r * 64 + c) * B1_LD + Q_OFF + h * 128 + 8 * g;
        bf16x8 qf[4];
#pragma unroll
        for (int s = 0; s < 4; ++s) qf[s] = *(const bf16x8*)(qp + 32 * s);
        f32x4 sacc[16];
#pragma unroll
        for (int kb = 0; kb < 16; ++kb) { const int ir = kb >> 1, hh = kb & 1;
            const bf16_t* kp = B1 + (seqbase + (size_t)(rs + ir) * 64 + sp + 16 * hh + l15) * B1_LD + K_OFF + h * 128 + 8 * g;
            bf16x8 kf[4];
#pragma unroll
            for (int s = 0; s < 4; ++s) kf[s] = *(const bf16x8*)(kp + 32 * s);
            f32x4 ac = (f32x4){0.f, 0.f, 0.f, 0.f};
#pragma unroll
            for (int s = 0; s < 4; ++s) ac = __builtin_amdgcn_mfma_f32_16x16x32_bf16(kf[s], qf[s], ac, 0, 0, 0);
            sacc[kb] = ac; }
        const LAS float* tb = btab + h * 465;
        float mx = -1e30f;
#pragma unroll
        for (int kb = 0; kb < 16; ++kb) { const int ir = kb >> 1, hh = kb & 1;
#pragma unroll
            for (int i = 0; i < 4; ++i) { const int kc = sp + 16 * hh + 4 * g + i; const bool valid = (kc >= cs) && (kc < cs + 16);
                int bidx = (rs + ir - r + 7) * 31 + (kc - c + 15); bidx = valid ? bidx : 0;
                const float bias = tb[bidx]; const float sv = valid ? sacc[kb][i] * scale + bias : -1e30f;
                sacc[kb][i] = sv; mx = fmaxf(mx, sv); } }
        mx = fmaxf(mx, __shfl_xor(mx, 16)); mx = fmaxf(mx, __shfl_xor(mx, 32));
        float sum = 0.f;
#pragma unroll
        for (int kb = 0; kb < 16; ++kb)
#pragma unroll
            for (int i = 0; i < 4; ++i) { const float p = __expf(sacc[kb][i] - mx); sum += p; sacc[kb][i] = p; }
        sum += __shfl_xor(sum, 16); sum += __shfl_xor(sum, 32);
        const float inv = 1.0f / sum;
        bf16x8 pf[8];
#pragma unroll
        for (int ks = 0; ks < 8; ++ks) { u32x4 w; w.x = cvt_pk_bf16(sacc[2 * ks][0], sacc[2 * ks][1]); w.y = cvt_pk_bf16(sacc[2 * ks][2], sacc[2 * ks][3]);
            w.z = cvt_pk_bf16(sacc[2 * ks + 1][0], sacc[2 * ks + 1][1]); w.w = cvt_pk_bf16(sacc[2 * ks + 1][2], sacc[2 * ks + 1][3]); pf[ks] = __builtin_bit_cast(bf16x8, w); }
        f32x4 oacc[8];
#pragma unroll
        for (int nb = 0; nb < 8; ++nb) oacc[nb] = (f32x4){0.f, 0.f, 0.f, 0.f};
        const int q4 = l15 >> 2, p4 = l15 & 3;
#pragma unroll
        for (int pass = 0; pass < 2; ++pass) {
            __syncthreads();
#pragma unroll
            for (int b8 = 0; b8 < 2; ++b8) { u32x4 tmp[8];
#pragma unroll
                for (int it = 0; it < 8; ++it) { const int cidx = (b8 * 8 + it) * 512 + tid; const int tk = cidx >> 5, hs = (cidx >> 4) & 1, ch = cidx & 15;
                    tmp[it] = *(const u32x4*)(B1 + (seqbase + (size_t)(rs + 4 * pass) * 64 + tk) * B1_LD + V_OFF + (2 * hp + hs) * 128 + ch * 8); }
#pragma unroll
                for (int it = 0; it < 8; ++it) { const int cidx = (b8 * 8 + it) * 512 + tid; const int tk = cidx >> 5, hs = (cidx >> 4) & 1, ch = cidx & 15;
                    *(LAS u32x4*)(lds + hs * 65536 + 256 * tk + 16 * (ch ^ swz16(tk))) = tmp[it]; } }
            __syncthreads();
            const LAS unsigned char* vb = lds + hsel * 65536;
#pragma unroll
            for (int ksl = 0; ksl < 4; ++ksl) {
                const int row1 = ksl * 64 + sp + 4 * g + q4, row2 = row1 + 16;
#pragma unroll
                for (int nb = 0; nb < 8; ++nb) { const int ch = 2 * nb + (p4 >> 1);
                    const s16x4 t1 = vtr(vb + 256 * row1 + 16 * (ch ^ swz16(row1)) + 8 * (p4 & 1));
                    const s16x4 t2 = vtr(vb + 256 * row2 + 16 * (ch ^ swz16(row2)) + 8 * (p4 & 1));
                    oacc[nb] = __builtin_amdgcn_mfma_f32_16x16x32_bf16(cat8(t1, t2), pf[pass * 4 + ksl], oacc[nb], 0, 0, 0); } }
        }
        bf16_t* op = B1 + (seqbase + (size_t)r * 64 + c) * B1_LD + ooff + h * 128 + 4 * g;
#pragma unroll
        for (int nb = 0; nb < 8; ++nb) { u32x2 w; w.x = cvt_pk_bf16(oacc[nb][0] * inv, oacc[nb][1] * inv); w.y = cvt_pk_bf16(oacc[nb][2] * inv, oacc[nb][3] * inv); *(u32x2*)(op + 16 * nb) = w; }
    }
    __syncthreads();
}

__device__ __forceinline__ int f_off(int row, int ch) { return 512 * row + 16 * (ch ^ swz16(row)); }

__device__ __forceinline__ void four1_phase(LAS unsigned char* lds, const bf16_t* B1, bf16_t* Z, int chunk, int vcu, int G, int tid) {
    const int wave = __builtin_amdgcn_readfirstlane(tid >> 6), lane = tid & 63, l15 = lane & 15, g = lane >> 4, q4 = l15 >> 2, p4 = l15 & 3;
    const int N2 = chunk ? 64 : 128, nseq = chunk ? 2 : 1, T = 128 * N2;
    const int nunits = nseq * N2 * 4, per = (nunits + G - 1) / G;
    const int k1 = 16 * wave + l15;
    bf16x8 Fc[4], Fs[4];
#pragma unroll
    for (int s = 0; s < 4; ++s) { unsigned wc_[4], ws_[4];
#pragma unroll
        for (int jj = 0; jj < 4; ++jj) { float c0, s0, c1, s1; const int t1a = 32 * s + 8 * g + 2 * jj, t1b = t1a + 1;
            sincospif((float)((k1 * t1a) & 127) * (1.0f / 64.0f), &s0, &c0); sincospif((float)((k1 * t1b) & 127) * (1.0f / 64.0f), &s1, &c1);
            const float sc = 0.08838834764831845f;
            wc_[jj] = cvt_pk_bf16(c0 * sc, c1 * sc); ws_[jj] = cvt_pk_bf16(s0 * sc, s1 * sc); }
        Fc[s] = __builtin_bit_cast(bf16x8, (u32x4){wc_[0], wc_[1], wc_[2], wc_[3]}); Fs[s] = __builtin_bit_cast(bf16x8, (u32x4){ws_[0], ws_[1], ws_[2], ws_[3]}); }
    const int trow0 = tid >> 5, tch = tid & 31;
    u32x4 treg[8];
    if (vcu * per < nunits) { const int unit = vcu * per; const int gq = unit & 3, rest = unit >> 2, t2 = rest % N2, seq = rest / N2;
        const bf16_t* tb = B1 + ((size_t)seq * T + (size_t)trow0 * N2 + t2) * B1_LD + VR_OFF + gq * 256 + tch * 8;
#pragma unroll
        for (int it = 0; it < 8; ++it) treg[it] = *(const u32x4*)(tb + (size_t)it * 16 * N2 * B1_LD); }
    for (int ui = 0; ui < per; ++ui) {
        const int unit = vcu * per + ui; if (unit >= nunits) break;
        const int gq = unit & 3, rest = unit >> 2, t2 = rest % N2, seq = rest / N2;
        const size_t seqbase = (size_t)seq * T;
        __syncthreads();
#pragma unroll
        for (int it = 0; it < 8; ++it) *(LAS u32x4*)(lds + f_off(16 * it + trow0, tch)) = treg[it];
        if (ui + 1 < per && unit + 1 < nunits) { const int un = unit + 1; const int gqn = un & 3, restn = un >> 2, t2n = restn % N2, seqn = restn / N2;
            const bf16_t* tb = B1 + ((size_t)seqn * T + (size_t)trow0 * N2 + t2n) * B1_LD + VR_OFF + gqn * 256 + tch * 8;
#pragma unroll
            for (int it = 0; it < 8; ++it) treg[it] = *(const u32x4*)(tb + (size_t)it * 16 * N2 * B1_LD); }
        __syncthreads();
        float cph, sph; sincospif((float)(k1 * t2) * (2.0f / (float)T), &sph, &cph);
        bf16_t* zrow = Z + (seqbase + (size_t)k1 * N2 + t2) * Z_LD + gq * 512 + 8 * g;
#pragma unroll 2
        for (int nb = 0; nb < 16; ++nb) {
            f32x4 ac = (f32x4){0.f, 0.f, 0.f, 0.f}, as = (f32x4){0.f, 0.f, 0.f, 0.f};
#pragma unroll
            for (int s = 0; s < 4; ++s) { const int r1 = 32 * s + 8 * g + q4, r2 = r1 + 4, ch = 2 * nb + (p4 >> 1);
                const bf16x8 af = cat8(vtr(lds + f_off(r1, ch) + 8 * (p4 & 1)), vtr(lds + f_off(r2, ch) + 8 * (p4 & 1)));
                ac = __builtin_amdgcn_mfma_f32_16x16x32_bf16(af, Fc[s], ac, 0, 0, 0); as = __builtin_amdgcn_mfma_f32_16x16x32_bf16(af, Fs[s], as, 0, 0, 0); }
            u32x4 w;
            w.x = cvt_pk_bf16(ac[0] * cph - as[0] * sph, -as[0] * cph - ac[0] * sph); w.y = cvt_pk_bf16(ac[1] * cph - as[1] * sph, -as[1] * cph - ac[1] * sph);
            w.z = cvt_pk_bf16(ac[2] * cph - as[2] * sph, -as[2] * cph - ac[2] * sph); w.w = cvt_pk_bf16(ac[3] * cph - as[3] * sph, -as[3] * cph - ac[3] * sph);
            *(u32x4*)(zrow + 32 * nb) = w; }
    }
    __syncthreads();
}

__device__ __forceinline__ void four2_phase(LAS unsigned char* lds, const bf16_t* Z, bf16_t* B1, int chunk, int vcu, int G, int tid) {
    const int wave = __builtin_amdgcn_readfirstlane(tid >> 6), lane = tid & 63, l15 = lane & 15, g = lane >> 4, q4 = l15 >> 2, p4 = l15 & 3;
    const int N2 = chunk ? 64 : 128, nseq = chunk ? 2 : 1, T = 128 * N2;
    const int nunits = nseq * 128 * 8, per = (nunits + G - 1) / G;
    const int nkb = N2 >> 4, kb = wave % nkb, npart = wave / nkb, nbn = 16 / (8 / nkb), nsteps = N2 >> 5;
    const int k2 = 16 * kb + l15;
    const float sc = chunk ? 0.125f : 0.08838834764831845f; const float angs = 2.0f / (float)N2;
    bf16x8 Fc[4], Fs[4];
#pragma unroll
    for (int s = 0; s < 4; ++s) { unsigned wc_[4], ws_[4];
#pragma unroll
        for (int jj = 0; jj < 4; ++jj) { float c0, s0, c1, s1; const int ta = 32 * s + 8 * g + 2 * jj, tb = ta + 1;
            sincospif((float)((k2 * ta) & (N2 - 1)) * angs, &s0, &c0); sincospif((float)((k2 * tb) & (N2 - 1)) * angs, &s1, &c1);
            wc_[jj] = cvt_pk_bf16(c0 * sc, c1 * sc); ws_[jj] = cvt_pk_bf16(s0 * sc, s1 * sc); }
        Fc[s] = __builtin_bit_cast(bf16x8, (u32x4){wc_[0], wc_[1], wc_[2], wc_[3]}); Fs[s] = __builtin_bit_cast(bf16x8, (u32x4){ws_[0], ws_[1], ws_[2], ws_[3]}); }
    const int nchunks = N2 * 32 / 512;
    const int trow0 = tid >> 5, tch = tid & 31;
    u32x4 treg[8];
    if (vcu * per < nunits) { const int unit = vcu * per; const int cb = unit & 7, rest = unit >> 3, k1 = rest & 127, seq = rest >> 7;
        const bf16_t* tb = Z + ((size_t)seq * T + (size_t)k1 * N2 + trow0) * Z_LD + cb * 256 + tch * 8;
#pragma unroll
        for (int it = 0; it < 8; ++it) if (it < nchunks) treg[it] = *(const u32x4*)(tb + (size_t)it * 16 * Z_LD); }
    for (int ui = 0; ui < per; ++ui) {
        const int unit = vcu * per + ui; if (unit >= nunits) break;
        const int cb = unit & 7, rest = unit >> 3, k1 = rest & 127, seq = rest >> 7;
        const size_t seqbase = (size_t)seq * T;
        __syncthreads();
#pragma unroll
        for (int it = 0; it < 8; ++it) if (it < nchunks) *(LAS u32x4*)(lds + f_off(16 * it + trow0, tch)) = treg[it];
        if (ui + 1 < per && unit + 1 < nunits) { const int un = unit + 1; const int cbn = un & 7, restn = un >> 3, k1n = restn & 127, seqn = restn >> 7;
            const bf16_t* tb = Z + ((size_t)seqn * T + (size_t)k1n * N2 + trow0) * Z_LD + cbn * 256 + tch * 8;
#pragma unroll
            for (int it = 0; it < 8; ++it) if (it < nchunks) treg[it] = *(const u32x4*)(tb + (size_t)it * 16 * Z_LD); }
        __syncthreads();
        bf16_t* orow = B1 + (seqbase + (size_t)k1 + 128 * (size_t)k2) * B1_LD + cb * 128 + 2 * g;
        for (int nbi = 0; nbi < nbn; ++nbi) { const int nb = npart * nbn + nbi;
            f32x4 pc = (f32x4){0.f, 0.f, 0.f, 0.f}, ps = (f32x4){0.f, 0.f, 0.f, 0.f};
#pragma unroll
            for (int s = 0; s < 4; ++s) { if (s < nsteps) { const int r1 = 32 * s + 8 * g + q4, r2 = r1 + 4, ch = 2 * nb + (p4 >> 1);
                const bf16x8 af = cat8(vtr(lds + f_off(r1, ch) + 8 * (p4 & 1)), vtr(lds + f_off(r2, ch) + 8 * (p4 & 1)));
                pc = __builtin_amdgcn_mfma_f32_16x16x32_bf16(af, Fc[s], pc, 0, 0, 0); ps = __builtin_amdgcn_mfma_f32_16x16x32_bf16(af, Fs[s], ps, 0, 0, 0); } }
            const unsigned vr = cvt_pk_bf16(pc[0] + ps[1], pc[2] + ps[3]), vi = cvt_pk_bf16(pc[1] - ps[0], pc[3] - ps[2]);
            *(unsigned*)(orow + VR_OFF + 8 * nb) = vr; *(unsigned*)(orow + VI_OFF + 8 * nb) = vi; }
    }
    __syncthreads();
}


#define XB_TMO      128
#define XB_XCNT(j)  (256  + 64 * (j))
#define XB_XSUB(j)  (1280 + 64 * (j))
#define XB_XGEN(j)  (2304 + 64 * (j))
#define XB_TOP      3328
#define XB_TOPGEN   3392
#define XCD_BAR_WORDS 3456
#define XB_SPIN_CAP (1u << 18)
__device__ __forceinline__ unsigned xb_ld(unsigned* p)              { return __hip_atomic_load(p, __ATOMIC_RELAXED, __HIP_MEMORY_SCOPE_AGENT); }
__device__ __forceinline__ unsigned xb_add(unsigned* p, unsigned v) { return __hip_atomic_fetch_add(p, v, __ATOMIC_RELAXED, __HIP_MEMORY_SCOPE_AGENT); }
__device__ __forceinline__ unsigned xb_xcc_id() { return (unsigned)__builtin_amdgcn_s_getreg((3 << 11) | 20) & 0xFu; }
#define XB_SPIN(cond, bar) do { unsigned _sp = 0; while (cond) { __builtin_amdgcn_s_sleep(1); \
    if ((++_sp & 255u) == 0u) { if (xb_ld(&(bar)[XB_TMO])) break; if (_sp > XB_SPIN_CAP) { atomicAdd(&(bar)[XB_TMO], 1u); break; } } } } while (0)
struct XcdBarrier { unsigned* bar; unsigned x; volatile LAS unsigned* st; };
__device__ __forceinline__ XcdBarrier xcd_barrier_post(unsigned* bar, volatile LAS unsigned* st) {
    XcdBarrier b; b.bar = bar; b.x = xb_xcc_id(); b.st = st;
    if (threadIdx.x == 0) (void)xb_add(&bar[XB_XCNT(b.x)], 1u);
    return b;
}
__device__ __forceinline__ void xcd_barrier_complete(unsigned* bar, unsigned x, unsigned& nloc, unsigned& nx) {
    const unsigned G = gridDim.x * gridDim.y * gridDim.z;
    unsigned sum, cnt, mine, sp = 0u;
    for (;;) {
        sum = 0u; cnt = 0u; mine = 0u;
#pragma unroll
        for (unsigned j = 0; j < 16; ++j) { const unsigned c = xb_ld(&bar[XB_XCNT(j)]); sum += c; cnt += (c > 0u) ? 1u : 0u; mine = (j == x) ? c : mine; }
        if (sum == G) break;
        __builtin_amdgcn_s_sleep(1);
        if ((++sp & 255u) == 0u) { if (xb_ld(&bar[XB_TMO])) break; if (sp > XB_SPIN_CAP) { atomicAdd(&bar[XB_TMO], 1u); break; } }
    }
    nloc = mine > 0u ? mine : 1u; nx = cnt > 0u ? cnt : 1u;
}
__device__ __forceinline__ void xcd_barrier(const XcdBarrier& b) {
    asm volatile("s_waitcnt vmcnt(0)" ::: "memory");
    __syncthreads();
    if (threadIdx.x == 0) {
        unsigned* bar = b.bar;
        __builtin_amdgcn_s_waitcnt(0);
        unsigned nloc = b.st[0], nx = b.st[1];
        if (nloc == 0u) { xcd_barrier_complete(bar, b.x, nloc, nx); b.st[0] = nloc; b.st[1] = nx; }
        const unsigned old = xb_add(&bar[XB_XSUB(b.x)], 1u);
        const unsigned gen = old / nloc;
        if (old + 1u == (gen + 1u) * nloc) {
            __builtin_amdgcn_fence(__ATOMIC_RELEASE, "agent");
            asm volatile("s_waitcnt vmcnt(0)" ::: "memory");
            const unsigned og = xb_add(&bar[XB_TOP], 1u);
            const unsigned tg = og / nx;
            if (og + 1u == (tg + 1u) * nx) xb_add(&bar[XB_TOPGEN], 1u);
            else XB_SPIN(xb_ld(&bar[XB_TOPGEN]) == tg, bar);
            __builtin_amdgcn_fence(__ATOMIC_ACQUIRE, "agent");
            xb_add(&bar[XB_XGEN(b.x)], 1u);
            asm volatile("s_waitcnt vmcnt(0)" ::: "memory");
        } else {
            XB_SPIN(xb_ld(&bar[XB_XGEN(b.x)]) == gen, bar);
            __builtin_amdgcn_fence(__ATOMIC_ACQUIRE, "agent");
            asm volatile("s_waitcnt vmcnt(0)" ::: "memory");
        }
    }
    __syncthreads();
}

enum { K_P1 = 0, K_ATT = 1, K_F2 = 2, K_P3 = 3, K_P4 = 4, K_LN1 = 5, K_P5 = 6, K_P6 = 7, K_LN2 = 8 };
constexpr int PH_PER_LAYER = 13, N_PHASES = 1 + DEPTH * PH_PER_LAYER;

__global__ void __launch_bounds__(512, 2) fwd_mega(Args a) {
    extern __shared__ __attribute__((aligned(16))) unsigned char lds_raw[];
    LAS unsigned char* lds = (LAS unsigned char*)lds_raw;
    cg::grid_group grid = cg::this_grid();
    const int G0 = gridDim.x, bx0 = blockIdx.x;
    unsigned char* ws = a.ws;
    bf16_t* Bt1 = (bf16_t*)(ws + WS_BT1); bf16_t* Bt3 = (bf16_t*)(ws + WS_BT3); bf16_t* WfT = (bf16_t*)(ws + WS_WFT); bf16_t* Bt4 = (bf16_t*)(ws + WS_BT4);
    bf16_t* Bt5 = (bf16_t*)(ws + WS_BT5); bf16_t* Bt6 = (bf16_t*)(ws + WS_BT6); bf16_t* Tab = (bf16_t*)(ws + WS_TAB);
    bf16_t* XB = (bf16_t*)(ws + WS_XB); bf16_t* B1 = (bf16_t*)(ws + WS_B1); bf16_t* Gt = (bf16_t*)(ws + WS_G); bf16_t* Z = (bf16_t*)(ws + WS_Z); bf16_t* Hb = (bf16_t*)(ws + WS_H);
    bf16_t* YLA = (bf16_t*)(ws + WS_BT1); bf16_t* YLB = (bf16_t*)(ws + WS_YB);
    float* X = a.out; bf16_t* Y16 = (bf16_t*)a.out; bf16_t* MbAll = (bf16_t*)a.out + (size_t)TALL * DM;
    volatile LAS unsigned* bst = (volatile LAS unsigned*)(lds + 147440);
    if (threadIdx.x < 2) bst[threadIdx.x] = 0u;
    __syncthreads();
    const XcdBarrier xbar = xcd_barrier_post((unsigned*)(ws + WS_CTL), bst);

    for (int ph = a.ph_lo; ph < a.ph_hi; ++ph) {
        int tid = threadIdx.x; asm volatile("" : "+v"(tid));
        int G = G0, bx = bx0; asm volatile("" : "+s"(G), "+s"(bx));
        const int vcu = (G % 8 == 0) ? (bx % 8) * (G / 8) + bx / 8 : bx; const int NGW = G * 8;
        const int lane = tid & 63, wave = __builtin_amdgcn_readfirstlane(tid >> 6), gw = vcu * 8 + wave;
        if (ph == 0) {
            wphase(a, 0, lds, gw, NGW, wave, lane);
            for (int m = gw; m < TALL; m += NGW) { const float* src = (m < CHT) ? a.in[0] + (size_t)m * DM : a.in[1] + (size_t)(m - CHT) * DM;
                ln_in_row(src, XB + (size_t)m * DM, a.in[2], a.in[3], lane); }
        } else {
            const int layer = (ph - 1) / PH_PER_LAYER, r = (ph - 1) % PH_PER_LAYER;
            const int chunk = (r < 8) ? r / 4 : 0, kind = (r < 8) ? r % 4 : r - 4;
            if (kind == K_P1) {
                { pg8::Gemm gm{XB + (size_t)chunk * CHT * DM, Bt1, DM, DM, DM}; pg8::StaticOrder S; S.init(CHT, 8192, G, bx);
                  pg8::EpiP1 E{B1, Gt, a.in[9] + (size_t)layer * 4096};
                  pg8::gemm_phase<pg8::EpiP1>(lds, gm, S, E, tid); }
                if (chunk == 0) { pg8::Gemm gm{WfT, Tab, 256, 256, 256}; pg8::StaticOrder S; S.init(8192, 512, G, bx);
                  pg8::EpiFold E{Bt3};
                  pg8::gemm_phase<pg8::EpiFold>(lds, gm, S, E, tid); }
            } else if (kind == K_ATT) {
                attn_phase(lds, B1, a.in[5] + (size_t)layer * 8 * 465, chunk, vcu, G, tid, Q_OFF);
                four1_phase(lds, B1, Z, chunk, vcu, G, tid);
            } else if (kind == K_F2) {
                four2_phase(lds, Z, B1, chunk, vcu, G, tid);
            } else if (kind == K_P3) {
                pg8::Gemm gm{B1, Bt3, B1_LD, 3072, 3072}; pg8::StaticOrder S; S.init(CHT, DM, G, bx);
                pg8::EpiP3 E{Gt, MbAll + (size_t)chunk * CHT * DM};
                pg8::gemm_phase<pg8::EpiP3>(lds, gm, S, E, tid);
            } else if (kind == K_P4) {
                pg8::Gemm gm{MbAll, Bt4, MB_LD, DM, DM}; pg8::StaticOrder S; S.init(TALL, DM, G, bx);
                pg8::EpiY E{Y16, Y16, 1 << 30};
                pg8::gemm_phase<pg8::EpiY>(lds, gm, S, E, tid);
            } else if (kind == K_LN1) {
                const float* gam = a.in[11] + (size_t)layer * DM; const float* bet = a.in[12] + (size_t)layer * DM;
                for (int m = gw; m < TALL; m += NGW) ln_res16_row(XB + (size_t)m * DM, Y16 + (size_t)m * DM, gam, bet, lane);
            } else if (kind == K_P5) {
                pg8::Gemm gm{XB, Bt5, DM, DM, DM}; pg8::StaticOrder S; S.init(TALL, 2 * DFF, G, bx);
                pg8::EpiSwiglu E{Hb};
                pg8::gemm_phase<pg8::EpiSwiglu>(lds, gm, S, E, tid);
            } else if (kind == K_P6) {
                pg8::Gemm gm{Hb, Bt6, H_LD, DFF, DFF}; pg8::StaticOrder S; S.init(TALL, DM, G, bx);
                const pg8::EpiY E = (layer + 1 < DEPTH) ? pg8::EpiY{Y16, Y16, 1 << 30} : pg8::EpiY{YLA, YLB - (size_t)25600 * DM, 100};
                pg8::gemm_phase<pg8::EpiY>(lds, gm, S, E, tid);
            } else {
                const float* gam = a.in[16] + (size_t)layer * DM; const float* bet = a.in[17] + (size_t)layer * DM;
                if (layer + 1 < DEPTH) { for (int m = gw; m < TALL; m += NGW) ln_res16_row(XB + (size_t)m * DM, Y16 + (size_t)m * DM, gam, bet, lane); }
                else { for (int m = gw; m < TALL; m += NGW) ln_res_final16_row(XB + (size_t)m * DM, (m < 25600 ? YLA : YLB - (size_t)25600 * DM) + (size_t)m * DM, X + (size_t)m * DM, gam, bet, lane); }
                if (layer + 1 < DEPTH) wphase(a, layer + 1, lds, gw, NGW, wave, lane);
            }
        }
        if (ph + 1 < a.ph_hi) {
            if (a.ph_hi > (1 << 20)) grid.sync();
            xcd_barrier(xbar);
        }
    }
}

extern "C" void kernel_launch(void* const* d_in, const int* in_sizes, int n_in, void* d_out, int out_size, void* d_ws, size_t ws_size, hipStream_t stream) {
    static int grid = 0;
    if (grid == 0) {
        if (n_in != 18 || out_size != TALL * DM || ws_size < WS_END) { fprintf(stderr, "kernel_launch: unexpected shapes (n_in %d out %d ws %zu, need ws >= %zu)\n", n_in, out_size, ws_size, (size_t)WS_END); grid = -1; return; }
        int dev = 0, cus = 0, per_cu = 0;
        hipGetDevice(&dev); hipDeviceGetAttribute(&cus, hipDeviceAttributeMultiprocessorCount, dev);
        if (hipFuncSetAttribute((const void*)fwd_mega, hipFuncAttributeMaxDynamicSharedMemorySize, LDS_BYTES) != hipSuccess) { fprintf(stderr, "kernel_launch: hipFuncSetAttribute failed\n"); grid = -1; return; }
        if (hipOccupancyMaxActiveBlocksPerMultiprocessor(&per_cu, (const void*)fwd_mega, 512, LDS_BYTES) != hipSuccess || per_cu < 1) { fprintf(stderr, "kernel_launch: occupancy query says %d\n", per_cu); per_cu = 1; }
        (void)hipGetLastError();
        grid = cus * 1;
    }
    if (grid < 0) return;
    if (hipMemsetAsync((char*)d_ws + WS_CTL, 0, 65536, stream) != hipSuccess) { fprintf(stderr, "kernel_launch: memset failed\n"); return; }
    Args a{};
    for (int i = 0; i < 18; ++i) a.in[i] = (const float*)d_in[i];
    a.out = (float*)d_out; a.ws = (unsigned char*)d_ws;
#if MK_PER_PHASE
    for (int ph = 0; ph < N_PHASES; ++ph) { a.ph_lo = ph; a.ph_hi = ph + 1; hipLaunchKernelGGL(fwd_mega, dim3(grid), dim3(512), LDS_BYTES, stream, a); }
#else
    a.ph_lo = 0; a.ph_hi = N_PHASES;
    void* args[] = {&a};
    hipError_t e = hipLaunchCooperativeKernel((const void*)fwd_mega, dim3(grid), dim3(512), args, LDS_BYTES, stream);
    if (e != hipSuccess) fprintf(stderr, "cooperative launch failed: %s (grid %d)\n", hipGetErrorString(e), grid);
#endif
}
```

```cpp
#include <hip/hip_runtime.h>
#include <hip/hip_cooperative_groups.h>
#include <cstdio>
#include <cstdint>
namespace cg = cooperative_groups;

#define LAS __attribute__((address_space(3)))
typedef unsigned short bf16_t;
typedef short bf16x8 __attribute__((ext_vector_type(8)));
typedef short s16x4 __attribute__((ext_vector_type(4)));
typedef float f32x4 __attribute__((ext_vector_type(4)));
typedef float f32x2 __attribute__((ext_vector_type(2)));
typedef unsigned u32x4 __attribute__((ext_vector_type(4)));
typedef unsigned u32x2 __attribute__((ext_vector_type(2)));

#ifndef MK_PER_PHASE
#define MK_PER_PHASE 0
#endif

constexpr int DM = 2048, TALL = 32768, CHT = 16384, DEPTH = 2, DFF = 5632;
constexpr int B1_LD = 5120, Q_OFF = 0, VR_OFF = 1024, VI_OFF = 2048, K_OFF = 3072, V_OFF = 4096;
constexpr int G_LD = 4096, Z_LD = 2048, MB_LD = 2048, H_LD = 5632;
constexpr float LN_EPS = 1e-5f;
constexpr float ALPHA = 1.41421356237309515f;

constexpr size_t MiB = 1u << 20;
constexpr size_t WS_BT1 = 0, WS_BT3 = 32 * MiB, WS_WFT = 44 * MiB, WS_BT4 = 48 * MiB, WS_BT5 = 56 * MiB, WS_BT6 = 100 * MiB, WS_TAB = 122 * MiB;
constexpr size_t WS_XB = 124 * MiB, WS_R = 252 * MiB, WS_B1 = WS_R, WS_G = WS_R + 160 * MiB, WS_Z = WS_R + 288 * MiB, WS_H = WS_R, WS_CTL = WS_R + 352 * MiB, WS_YB = WS_CTL + 1 * MiB, WS_END = WS_YB + 28 * MiB;
constexpr int LDS_BYTES = 147456;

typedef __bf16 bf16x2_t __attribute__((ext_vector_type(2)));
__device__ __forceinline__ unsigned cvt_pk_bf16(float lo, float hi) { const f32x2 v = {lo, hi}; const bf16x2_t b = __builtin_convertvector(v, bf16x2_t); return __builtin_bit_cast(unsigned, b); }
__device__ __forceinline__ float bf_lo(unsigned w) { return __uint_as_float(w << 16); }
__device__ __forceinline__ float bf_hi(unsigned w) { return __uint_as_float(w & 0xffff0000u); }
__device__ __forceinline__ float rcpf_(float x) { return __builtin_amdgcn_rcpf(x); }
__device__ __forceinline__ float sigmoidf_(float x) { return rcpf_(1.0f + __builtin_amdgcn_exp2f(x * -1.4426950408889634f)); }

namespace pg8 {
constexpr int BM = 256, BK = 64, HALF = 128, HTB = HALF * BK * 2, STAGE_BYTES = 8 * HTB, NXCD = 8, WGM = 8;
__host__ __device__ __forceinline__ int lds_byte(int r, int c) { const int st = (r >> 4) * 2 + (c >> 5), rr = r & 15, cc = c & 31, ob = rr * 64 + cc * 2; return st * 1024 + (ob ^ (((ob >> 9) & 1) << 5)); }
__host__ __device__ __forceinline__ void stage_rc(int b, int& R, int& C) { const int st = b / 1024, sb = b % 1024, swz = sb ^ (((sb >> 9) & 1) << 5); R = (st >> 1) * 16 + swz / 64; C = (st & 1) * 32 + (swz % 64) / 2; }
__host__ __device__ __forceinline__ int perm32(int rho) { const int n = rho >> 4, i = rho & 15; return 8 * (i >> 2) + 4 * n + (i & 3); }

struct Unit { int pm, pn; };
struct Gemm { const bf16_t* A; const bf16_t* Bt; int lda, ldb, K; };

struct StaticOrder {
    int nM, nN, nwg, G, c;
    __host__ __device__ void init(int M, int N, int G_, int c_) { nM = M / BM; nN = N / BM; nwg = nM * nN; G = G_; c = c_; }
    __host__ __device__ bool next(int i, Unit& u) const {
        const long L = (long)i * G + c; if (L >= nwg) return false;
        int wgid = (int)L; { const int q = nwg / NXCD, r = nwg % NXCD, xcd = wgid % NXCD, off = wgid / NXCD; wgid = (xcd < r ? xcd * (q + 1) : r * (q + 1) + (xcd - r) * q) + off; }
        const int nig = WGM * nN, gid = wgid / nig, fm = gid * WGM, gsz = (nM - fm) < WGM ? (nM - fm) : WGM;
        u.pm = fm + ((wgid % nig) % gsz); u.pn = (wgid % nig) / gsz; return true;
    }
};

typedef f32x4 Acc[2][2][4][2];

struct EpiP1 {
    static constexpr bool PERM = true; static constexpr int MID_T = -1;
    bf16_t* B1; bf16_t* G; const float* bgate;
    __device__ __forceinline__ void mid(Acc&, const Unit&, int, int, int, int) const {}
    __device__ __forceinline__ void operator()(const Acc& acc, const Unit& u, int wr, int wc, int fr, int fq) const {
        const int row0 = u.pm * BM + wr * 64 + fr; const int ct = u.pn;
        if (ct < 16) {
            const int seg = ct >> 2;
            const int coff = (seg == 0 ? Q_OFF : seg == 1 ? K_OFF : seg == 2 ? V_OFF : VR_OFF) + (ct & 3) * 256 + wc * 32 + 8 * fq;
#pragma unroll
            for (int ai = 0; ai < 2; ++ai)
#pragma unroll
                for (int m = 0; m < 4; ++m) { bf16_t* rowp = B1 + (size_t)(row0 + ai * HALF + m * 16) * B1_LD + coff;
#pragma unroll
                    for (int bj = 0; bj < 2; ++bj) { const f32x4 v0 = acc[ai][bj][m][0], v1 = acc[ai][bj][m][1];
                        u32x4 w; w.x = cvt_pk_bf16(v0[0], v0[1]); w.y = cvt_pk_bf16(v0[2], v0[3]); w.z = cvt_pk_bf16(v1[0], v1[1]); w.w = cvt_pk_bf16(v1[2], v1[3]);
                        *(u32x4*)(rowp + bj * HALF) = w; } }
        } else {
            const int gcol0 = (ct - 16) * HALF + wc * 32 + 8 * fq;
            f32x4 ba[2], bf[2];
#pragma unroll
            for (int n = 0; n < 2; ++n) { ba[n] = *(const f32x4*)(bgate + gcol0 + 4 * n); bf[n] = *(const f32x4*)(bgate + DM + gcol0 + 4 * n); }
#pragma unroll
            for (int ai = 0; ai < 2; ++ai)
#pragma unroll
                for (int m = 0; m < 4; ++m) { bf16_t* rowp = G + (size_t)(row0 + ai * HALF + m * 16) * G_LD + gcol0;
                    f32x4 rr[2], gg[2];
#pragma unroll
                    for (int n = 0; n < 2; ++n) { const f32x4 va = acc[ai][0][m][n] + ba[n], vf = acc[ai][1][m][n] + bf[n];
#pragma unroll
                        for (int j = 0; j < 4; ++j) { const float ea = __builtin_amdgcn_exp2f(va[j] * -1.4426950408889634f), ef = __builtin_amdgcn_exp2f(vf[j] * -1.4426950408889634f);
                            gg[n][j] = rcpf_(1.0f + ef); rr[n][j] = (1.0f + ef) * rcpf_(1.0f + ea); } }
                    u32x4 w; w.x = cvt_pk_bf16(rr[0][0], rr[0][1]); w.y = cvt_pk_bf16(rr[0][2], rr[0][3]); w.z = cvt_pk_bf16(rr[1][0], rr[1][1]); w.w = cvt_pk_bf16(rr[1][2], rr[1][3]);
                    *(u32x4*)rowp = w;
                    u32x4 v; v.x = cvt_pk_bf16(gg[0][0], gg[0][1]); v.y = cvt_pk_bf16(gg[0][2], gg[0][3]); v.z = cvt_pk_bf16(gg[1][0], gg[1][1]); v.w = cvt_pk_bf16(gg[1][2], gg[1][3]);
                    *(u32x4*)(rowp + DM) = v; }
        }
    }
};

struct EpiP3 {
    static constexpr bool PERM = true; static constexpr int MID_T = 16;
    const bf16_t* __restrict__ G; bf16_t* __restrict__ Mb;
    __device__ __forceinline__ void mid(Acc& acc, const Unit& u, int wr, int wc, int fr, int fq) const {
        asm volatile("" : "+v"(fr), "+v"(fq));
        const int row0 = u.pm * BM + wr * 64 + fr, col0 = u.pn * BM + wc * 32 + 8 * fq;
#pragma unroll
        for (int ai = 0; ai < 2; ++ai) {
            u32x4 rr[4][2];
#pragma unroll
            for (int m = 0; m < 4; ++m)
#pragma unroll
                for (int bj = 0; bj < 2; ++bj) rr[m][bj] = *(const u32x4*)(G + (size_t)(row0 + ai * HALF + m * 16) * G_LD + col0 + bj * HALF);
#pragma unroll
            for (int m = 0; m < 4; ++m)
#pragma unroll
                for (int bj = 0; bj < 2; ++bj) { const u32x4 a = rr[m][bj]; f32x4 r0, r1;
                    r0[0] = bf_lo(a.x); r0[1] = bf_hi(a.x); r0[2] = bf_lo(a.y); r0[3] = bf_hi(a.y); r1[0] = bf_lo(a.z); r1[1] = bf_hi(a.z); r1[2] = bf_lo(a.w); r1[3] = bf_hi(a.w);
                    acc[ai][bj][m][0] *= r0; acc[ai][bj][m][1] *= r1; }
            asm volatile("" ::: "memory"); }
    }
    __device__ __forceinline__ void operator()(const Acc& acc, const Unit& u, int wr, int wc, int fr, int fq) const {
        const int row0 = u.pm * BM + wr * 64 + fr, col0 = u.pn * BM + wc * 32 + 8 * fq;
#pragma unroll
        for (int ai = 0; ai < 2; ++ai) {
            u32x4 gf[4][2];
#pragma unroll
            for (int m = 0; m < 4; ++m)
#pragma unroll
                for (int bj = 0; bj < 2; ++bj) gf[m][bj] = *(const u32x4*)(G + (size_t)(row0 + ai * HALF + m * 16) * G_LD + DM + col0 + bj * HALF);
#pragma unroll
            for (int m = 0; m < 4; ++m)
#pragma unroll
                for (int bj = 0; bj < 2; ++bj) { const u32x4 f = gf[m][bj]; const f32x4 v0 = acc[ai][bj][m][0], v1 = acc[ai][bj][m][1];
                    u32x4 w; w.x = cvt_pk_bf16(v0[0] * bf_lo(f.x), v0[1] * bf_hi(f.x)); w.y = cvt_pk_bf16(v0[2] * bf_lo(f.y), v0[3] * bf_hi(f.y));
                    w.z = cvt_pk_bf16(v1[0] * bf_lo(f.z), v1[1] * bf_hi(f.z)); w.w = cvt_pk_bf16(v1[2] * bf_lo(f.w), v1[3] * bf_hi(f.w));
                    *(u32x4*)(Mb + (size_t)(row0 + ai * HALF + m * 16) * MB_LD + col0 + bj * HALF) = w; }
            asm volatile("" ::: "memory"); }
    }
};

struct EpiY {
    static constexpr bool PERM = true; static constexpr int MID_T = -1;
    bf16_t* Y; bf16_t* Y2; int split;
    __device__ __forceinline__ void mid(Acc&, const Unit&, int, int, int, int) const {}
    __device__ __forceinline__ void operator()(const Acc& acc, const Unit& u, int wr, int wc, int fr, int fq) const {
        const int row0 = u.pm * BM + wr * 64 + fr, col0 = u.pn * BM + wc * 32 + 8 * fq;
        bf16_t* Yb = (u.pm < split) ? Y : Y2;
#pragma unroll
        for (int ai = 0; ai < 2; ++ai)
#pragma unroll
            for (int m = 0; m < 4; ++m) { bf16_t* rowp = Yb + (size_t)(row0 + ai * HALF + m * 16) * DM + col0;
#pragma unroll
                for (int bj = 0; bj < 2; ++bj) { const f32x4 v0 = acc[ai][bj][m][0], v1 = acc[ai][bj][m][1];
                    u32x4 w; w.x = cvt_pk_bf16(v0[0], v0[1]); w.y = cvt_pk_bf16(v0[2], v0[3]); w.z = cvt_pk_bf16(v1[0], v1[1]); w.w = cvt_pk_bf16(v1[2], v1[3]);
                    *(u32x4*)(rowp + bj * HALF) = w; } }
    }
};

struct EpiSwiglu {
    static constexpr bool PERM = true; static constexpr int MID_T = -1;
    bf16_t* H;
    __device__ __forceinline__ void mid(Acc&, const Unit&, int, int, int, int) const {}
    __device__ __forceinline__ void operator()(const Acc& acc, const Unit& u, int wr, int wc, int fr, int fq) const {
        const int row0 = u.pm * BM + wr * 64 + fr, col0 = u.pn * HALF + wc * 32 + 8 * fq;
#pragma unroll
        for (int ai = 0; ai < 2; ++ai)
#pragma unroll
            for (int m = 0; m < 4; ++m) { bf16_t* rowp = H + (size_t)(row0 + ai * HALF + m * 16) * H_LD + col0;
                f32x4 o0, o1;
#pragma unroll
                for (int j = 0; j < 4; ++j) { const float g0 = acc[ai][0][m][0][j], g1 = acc[ai][0][m][1][j];
                    o0[j] = g0 * sigmoidf_(g0) * acc[ai][1][m][0][j]; o1[j] = g1 * sigmoidf_(g1) * acc[ai][1][m][1][j]; }
                u32x4 w; w.x = cvt_pk_bf16(o0[0], o0[1]); w.y = cvt_pk_bf16(o0[2], o0[3]); w.z = cvt_pk_bf16(o1[0], o1[1]); w.w = cvt_pk_bf16(o1[2], o1[3]);
                *(u32x4*)rowp = w; }
    }
};

struct EpiFold {
    static constexpr bool PERM = true; static constexpr int MID_T = -1;
    bf16_t* Bt3;
    __device__ __forceinline__ void mid(Acc&, const Unit&, int, int, int, int) const {}
    __device__ __forceinline__ void operator()(const Acc& acc, const Unit& u, int wr, int wc, int fr, int fq) const {
        const int g = u.pm >> 3, d0 = (u.pm & 7) * 256 + wr * 64 + fr, col0 = 1024 + u.pn * 1024 + g * 256 + wc * 32 + 8 * fq;
#pragma unroll
        for (int ai = 0; ai < 2; ++ai)
#pragma unroll
            for (int m = 0; m < 4; ++m) { bf16_t* rowp = Bt3 + (size_t)(d0 + ai * HALF + m * 16) * 3072 + col0;
#pragma unroll
                for (int bj = 0; bj < 2; ++bj) { const f32x4 v0 = acc[ai][bj][m][0], v1 = acc[ai][bj][m][1];
                    u32x4 w; w.x = cvt_pk_bf16(v0[0], v0[1]); w.y = cvt_pk_bf16(v0[2], v0[3]); w.z = cvt_pk_bf16(v1[0], v1[1]); w.w = cvt_pk_bf16(v1[2], v1[3]);
                    *(u32x4*)(rowp + bj * HALF) = w; } }
    }
};

template <class Epi, bool ALIGN_EPI = true>
__device__ __forceinline__ void gemm_phase(LAS unsigned char* lds, const Gemm g, const StaticOrder& S, const Epi& E, const int tid) {
    const int wid = __builtin_amdgcn_readfirstlane(tid >> 6), lane = tid & 63, wr = wid >> 2, wc = wid & 3, fr = lane & 15, fq = lane >> 4;
    const int K = g.K; int nt = K / BK; asm volatile("" : "+s"(nt));
    unsigned voffA[2], voffB[2];
#pragma unroll
    for (int i = 0; i < 2; ++i) { int R, C; stage_rc(tid * 16 + i * 8192, R, C); const int Rb = Epi::PERM ? ((R & ~31) + perm32(R & 31)) : R;
        voffA[i] = (unsigned)(R * g.lda + C) * 2u; voffB[i] = (unsigned)(Rb * g.ldb + C) * 2u; }
    const size_t kstep = (size_t)(BK * 2);
    const size_t hA = (size_t)HALF * g.lda * 2, hB = (size_t)HALF * g.ldb * 2;
    const size_t tA = 2 * hA, tB = 2 * hB;
    const unsigned ldsw = (unsigned)wid * 1024u;
    const int aoff = lds_byte(wr * 64 + fr, fq * 8), boff = lds_byte(wc * 32 + fr, fq * 8);
#define PG8_SA(b, h) (((b) * 2 + (h)) * HTB)
#define PG8_SB(b, h) ((4 + (b) * 2 + (h)) * HTB)
#define PG8_STAGE(bufoff, gbase, voff) do { _Pragma("unroll") for (int _i = 0; _i < 2; ++_i) \
        __builtin_amdgcn_global_load_lds((const unsigned*)((const char*)(gbase) + (voff)[_i]), (LAS unsigned*)(lds + (bufoff) + ldsw + _i * 8192), 16, 0, 0); } while (0)
#define PG8_LDA(dst, b, h) do { _Pragma("unroll") for (int m = 0; m < 4; ++m) _Pragma("unroll") for (int k = 0; k < 2; ++k) dst[m][k] = *(const LAS bf16x8*)(lds + PG8_SA(b, h) + aoff + m * 2048 + k * 1024); } while (0)
#define PG8_LDB(dst, b, h) do { _Pragma("unroll") for (int n = 0; n < 2; ++n) _Pragma("unroll") for (int k = 0; k < 2; ++k) dst[n][k] = *(const LAS bf16x8*)(lds + PG8_SB(b, h) + boff + n * 2048 + k * 1024); } while (0)
#define PG8_MMA(ai, bj, At, Bt) do { __builtin_amdgcn_s_setprio(1); _Pragma("unroll") for (int m = 0; m < 4; ++m) _Pragma("unroll") for (int n = 0; n < 2; ++n) _Pragma("unroll") for (int k = 0; k < 2; ++k) \
        acc[ai][bj][m][n] = __builtin_amdgcn_mfma_f32_16x16x32_bf16(Bt[n][k], At[m][k], acc[ai][bj][m][n], 0, 0, 0); __builtin_amdgcn_s_setprio(0); } while (0)
#define PG8_WAIT_V(n) asm volatile("s_waitcnt vmcnt(" #n ")" ::: "memory")
#define PG8_WAIT_L(n) asm volatile("s_waitcnt lgkmcnt(" #n ")" ::: "memory")
#define PG8_BAR __builtin_amdgcn_s_barrier()
#define PG8_SCHED __builtin_amdgcn_sched_barrier(0)
    Unit cur, nxt; int ui = 0;
    if (!S.next(0, cur)) return;
    Acc acc;
#pragma unroll
    for (int a = 0; a < 2; ++a)
#pragma unroll
        for (int b = 0; b < 2; ++b)
#pragma unroll
            for (int m = 0; m < 4; ++m)
#pragma unroll
                for (int n = 0; n < 2; ++n) acc[a][b][m][n] = (f32x4){0.f, 0.f, 0.f, 0.f};
    bf16x8 At[4][2], B0[2][2], B1[2][2];
    const char* cA = (const char*)g.A + (size_t)cur.pm * tA; const char* cB = (const char*)g.Bt + (size_t)cur.pn * tB;
    PG8_STAGE(PG8_SB(0, 0), cB, voffB); PG8_STAGE(PG8_SB(0, 1), cB + hB, voffB); PG8_STAGE(PG8_SA(0, 0), cA, voffA); PG8_STAGE(PG8_SA(0, 1), cA + hA, voffA);
    if (wr == 1) PG8_BAR;
    PG8_WAIT_V(2); PG8_BAR;
    PG8_STAGE(PG8_SB(1, 0), cB + kstep, voffB); PG8_STAGE(PG8_SA(1, 0), cA + kstep, voffA); PG8_STAGE(PG8_SB(1, 1), cB + hB + kstep, voffB);
    PG8_WAIT_V(6); PG8_BAR;
    for (;;) {
        const bool has_next = S.next(ui + 1, nxt);
        const char* nA = has_next ? (const char*)g.A + (size_t)nxt.pm * tA : cA; const char* nB = has_next ? (const char*)g.Bt + (size_t)nxt.pn * tB : cB;
        for (int t = 0; t < nt; t += 2) {
            const bool last = (t == nt - 2);
            const char* a1 = cA + (size_t)(t + 1) * kstep;
            const char* a2 = last ? nA : cA + (size_t)(t + 2) * kstep; const char* b2 = last ? nB : cB + (size_t)(t + 2) * kstep;
            const char* a3 = a2 + kstep; const char* b3 = b2 + kstep;
            if constexpr (Epi::MID_T >= 0) { if (t == Epi::MID_T) { E.mid(acc, cur, wr, wc, fr, fq); PG8_SCHED; } }
            PG8_LDB(B0, 0, 0); PG8_LDB(B1, 0, 1); PG8_SCHED; PG8_LDA(At, 0, 0); PG8_STAGE(PG8_SA(1, 1), a1 + hA, voffA);
            PG8_WAIT_V(8); PG8_WAIT_L(0); PG8_BAR; PG8_MMA(0, 0, At, B0); PG8_MMA(0, 1, At, B1); PG8_BAR; PG8_SCHED;
            PG8_LDA(At, 0, 1); PG8_STAGE(PG8_SB(0, 0), b2, voffB); PG8_STAGE(PG8_SB(0, 1), b2 + hB, voffB); PG8_STAGE(PG8_SA(0, 0), a2, voffA);
            PG8_WAIT_V(8); PG8_WAIT_L(0); PG8_BAR; PG8_MMA(1, 0, At, B0); PG8_MMA(1, 1, At, B1); PG8_BAR; PG8_SCHED;
            PG8_LDB(B0, 1, 0); PG8_LDB(B1, 1, 1); PG8_SCHED; PG8_LDA(At, 1, 0); PG8_STAGE(PG8_SA(0, 1), a2 + hA, voffA);
            PG8_WAIT_V(8); PG8_WAIT_L(0); PG8_BAR; PG8_MMA(0, 0, At, B0); PG8_MMA(0, 1, At, B1); PG8_BAR; PG8_SCHED;
            PG8_LDA(At, 1, 1); PG8_STAGE(PG8_SB(1, 0), b3, voffB); PG8_STAGE(PG8_SB(1, 1), b3 + hB, voffB); PG8_STAGE(PG8_SA(1, 0), a3, voffA);
            PG8_WAIT_V(8); PG8_WAIT_L(0); PG8_BAR; PG8_MMA(1, 0, At, B0); PG8_MMA(1, 1, At, B1); PG8_BAR; PG8_SCHED;
        }
        if constexpr (ALIGN_EPI) { if (wr == 0) PG8_BAR; }
        E(acc, cur, wr, wc, fr, fq);
        if (!has_next) break;
#pragma unroll
        for (int a = 0; a < 2; ++a)
#pragma unroll
            for (int b = 0; b < 2; ++b)
#pragma unroll
                for (int m = 0; m < 4; ++m)
#pragma unroll
                    for (int n = 0; n < 2; ++n) acc[a][b][m][n] = (f32x4){0.f, 0.f, 0.f, 0.f};
        cur = nxt; cA = nA; cB = nB; ++ui;
        if constexpr (ALIGN_EPI) { if (wr == 1) PG8_BAR; }
    }
    PG8_WAIT_V(0);
    if constexpr (!ALIGN_EPI) { if (wr == 0) PG8_BAR; }
    PG8_BAR;
#undef PG8_SA
#undef PG8_SB
#undef PG8_STAGE
#undef PG8_LDA
#undef PG8_LDB
#undef PG8_MMA
#undef PG8_WAIT_V
#undef PG8_WAIT_L
#undef PG8_BAR
#undef PG8_SCHED
}
}

#define LDS_WAIT() asm volatile("s_waitcnt lgkmcnt(0)" ::: "memory")
__device__ __forceinline__ float wave_sum(float v) {
#pragma unroll
    for (int o = 1; o < 64; o <<= 1) v += __shfl_xor(v, o);
    return v;
}
__device__ __forceinline__ s16x4 vtr(const LAS unsigned char* p) { return __builtin_bit_cast(s16x4, __builtin_amdgcn_ds_read_tr16_b64_v4i16((LAS s16x4*)p)); }
__device__ __forceinline__ bf16x8 cat8(s16x4 a, s16x4 b) { bf16x8 r; r[0] = a[0]; r[1] = a[1]; r[2] = a[2]; r[3] = a[3]; r[4] = b[0]; r[5] = b[1]; r[6] = b[2]; r[7] = b[3]; return r; }
__device__ __forceinline__ int swz16(int row) { return ((row & 3) << 2) | ((row >> 2) & 3); }

struct Args {
    const float* in[18]; float* out; unsigned char* ws; int ph_lo, ph_hi;
};

__device__ __forceinline__ void transpose_item(const float* __restrict__ W, int ldw, int k0, int n0, bf16_t* WT, int ldo, int drow0, int dcol0, LAS float* scr, int lane) {
    float t32[32];
#pragma unroll
    for (int i = 0; i < 32; ++i) { const int kk = 2 * i + (lane >> 5); t32[i] = W[(size_t)(k0 + kk) * ldw + n0 + (lane & 31)]; }
#pragma unroll
    for (int i = 0; i < 32; ++i) { const int kk = 2 * i + (lane >> 5); scr[kk * 33 + (lane & 31)] = t32[i]; }
    LDS_WAIT(); asm volatile("" ::: "memory");
    const int c = lane & 7;
#pragma unroll
    for (int j = 0; j < 4; ++j) { const int n = (lane >> 3) + 8 * j; const LAS float* s = scr + (8 * c) * 33 + n;
        u32x4 o; o.x = cvt_pk_bf16(s[0 * 33], s[1 * 33]); o.y = cvt_pk_bf16(s[2 * 33], s[3 * 33]); o.z = cvt_pk_bf16(s[4 * 33], s[5 * 33]); o.w = cvt_pk_bf16(s[6 * 33], s[7 * 33]);
        *(u32x4*)(WT + (size_t)(drow0 + n) * ldo + dcol0 + 8 * c) = o; }
    LDS_WAIT(); asm volatile("" ::: "memory");
}

__device__ __forceinline__ void wphase(const Args& a, int layer, LAS unsigned char* lds, int gw, int NGW, int wave, int lane) {
    unsigned char* ws = a.ws;
    bf16_t* Bt1 = (bf16_t*)(ws + WS_BT1); bf16_t* Bt3 = (bf16_t*)(ws + WS_BT3); bf16_t* WfT = (bf16_t*)(ws + WS_WFT); bf16_t* Bt4 = (bf16_t*)(ws + WS_BT4);
    bf16_t* Bt5 = (bf16_t*)(ws + WS_BT5); bf16_t* Bt6 = (bf16_t*)(ws + WS_BT6); bf16_t* Tab = (bf16_t*)(ws + WS_TAB);
    const float* w_in = a.in[4] + (size_t)layer * DM * 4096; const float* w_att = a.in[6] + (size_t)layer * 1024 * DM; const float* w_four = a.in[7] + (size_t)layer * 1024 * DM;
    const float* w_gate = a.in[8] + (size_t)layer * DM * 4096; const float* w_out = a.in[10] + (size_t)layer * DM * DM;
    const float* w_fg = a.in[13] + (size_t)layer * DM * DFF; const float* w_fu = a.in[14] + (size_t)layer * DM * DFF; const float* w_fd = a.in[15] + (size_t)layer * DFF * DM;
    LAS float* scr = (LAS float*)(lds + wave * 16384);
    constexpr int I_IN = 32 * 128, I_ATT = 16 * 64, I_OUT = 32 * 64, I_FF = 32 * 176, I_FD = 88 * 64;
    constexpr int NITEMS = 2 * I_IN + 2 * I_ATT + I_OUT + 2 * I_FF + I_FD;
    for (int it = gw; it < NITEMS; it += NGW) {
        int r = it;
        if (r < I_IN) { const int kb = r / 128, nb = r % 128; transpose_item(w_in, 4096, 64 * kb, 32 * nb, Bt1, DM, 32 * nb, 64 * kb, scr, lane); continue; } r -= I_IN;
        if (r < I_IN) { const int kb = r / 128, nb = r % 128; const int n0 = 32 * nb, jj = n0 & 2047; transpose_item(w_gate, 4096, 64 * kb, n0, Bt1, DM, 4096 + 256 * (jj >> 7) + 128 * (n0 >> 11) + (jj & 127), 64 * kb, scr, lane); continue; } r -= I_IN;
        if (r < I_ATT) { const int kb = r / 64, nb = r % 64; transpose_item(w_att, DM, 64 * kb, 32 * nb, Bt3, 3072, 32 * nb, 64 * kb, scr, lane); continue; } r -= I_ATT;
        if (r < I_ATT) { const int kb = r / 64, nb = r % 64; const int k0 = 64 * kb; transpose_item(w_four, DM, k0, 32 * nb, WfT, 256, (k0 >> 8) * 2048 + 32 * nb, k0 & 255, scr, lane); continue; } r -= I_ATT;
        if (r < I_OUT) { const int kb = r / 64, nb = r % 64; transpose_item(w_out, DM, 64 * kb, 32 * nb, Bt4, DM, 32 * nb, 64 * kb, scr, lane); continue; } r -= I_OUT;
        if (r < I_FF) { const int kb = r / 176, nb = r % 176; const int n0 = 32 * nb; transpose_item(w_fg, DFF, 64 * kb, n0, Bt5, DM, 256 * (n0 >> 7) + (n0 & 127), 64 * kb, scr, lane); continue; } r -= I_FF;
        if (r < I_FF) { const int kb = r / 176, nb = r % 176; const int n0 = 32 * nb; transpose_item(w_fu, DFF, 64 * kb, n0, Bt5, DM, 256 * (n0 >> 7) + 128 + (n0 & 127), 64 * kb, scr, lane); continue; } r -= I_FF;
        { const int kb = r / 64, nb = r % 64; transpose_item(w_fd, DM, 64 * kb, 32 * nb, Bt6, DFF, 32 * nb, 64 * kb, scr, lane); }
    }
    for (int e = gw * 64 + lane; e < 512 * 256; e += NGW * 64) { const int kc = e & 255, c = (e >> 8) & 255, cs = e >> 16;
        float sv, cv; sincospif((float)((c * kc) & 255) * (1.0f / 128.0f), &sv, &cv); const float v = (cs ? sv : cv) * 0.0625f;
        Tab[e] = (bf16_t)(cvt_pk_bf16(v, 0.f) & 0xffffu); }
}

__device__ __forceinline__ void unpack8(const u32x4 w, float* v) { v[0] = bf_lo(w.x); v[1] = bf_hi(w.x); v[2] = bf_lo(w.y); v[3] = bf_hi(w.y); v[4] = bf_lo(w.z); v[5] = bf_hi(w.z); v[6] = bf_lo(w.w); v[7] = bf_hi(w.w); }
__device__ __forceinline__ void ln_core(float (&v)[4][8], const float* __restrict__ gam, const float* __restrict__ bet, int lane) {
    float s = 0.f;
#pragma unroll
    for (int j = 0; j < 4; ++j)
#pragma unroll
        for (int e = 0; e < 8; ++e) s += v[j][e];
    const float mean = wave_sum(s) * (1.f / DM); float s2 = 0.f;
#pragma unroll
    for (int j = 0; j < 4; ++j)
#pragma unroll
        for (int e = 0; e < 8; ++e) { v[j][e] -= mean; s2 += v[j][e] * v[j][e]; }
    const float rstd = 1.f / sqrtf(wave_sum(s2) * (1.f / DM) + LN_EPS);
#pragma unroll
    for (int j = 0; j < 4; ++j) { const f32x4 g0 = ((const f32x4*)gam)[2 * (lane + 64 * j)], g1 = ((const f32x4*)gam)[2 * (lane + 64 * j) + 1];
        const f32x4 b0 = ((const f32x4*)bet)[2 * (lane + 64 * j)], b1 = ((const f32x4*)bet)[2 * (lane + 64 * j) + 1];
#pragma unroll
        for (int e = 0; e < 4; ++e) { v[j][e] = v[j][e] * rstd * g0[e] + b0[e]; v[j][4 + e] = v[j][4 + e] * rstd * g1[e] + b1[e]; } }
}
__device__ __forceinline__ u32x4 pack8(const float* v) { u32x4 w; w.x = cvt_pk_bf16(v[0], v[1]); w.y = cvt_pk_bf16(v[2], v[3]); w.z = cvt_pk_bf16(v[4], v[5]); w.w = cvt_pk_bf16(v[6], v[7]); return w; }
__device__ __forceinline__ void ln_in_row(const float* src, bf16_t* dstb, const float* __restrict__ gam, const float* __restrict__ bet, int lane) {
    float v[4][8];
#pragma unroll
    for (int j = 0; j < 4; ++j) { const f32x4 a0 = ((const f32x4*)src)[2 * (lane + 64 * j)], a1 = ((const f32x4*)src)[2 * (lane + 64 * j) + 1];
#pragma unroll
        for (int e = 0; e < 4; ++e) { v[j][e] = a0[e]; v[j][4 + e] = a1[e]; } }
    ln_core(v, gam, bet, lane);
#pragma unroll
    for (int j = 0; j < 4; ++j) ((u32x4*)dstb)[lane + 64 * j] = pack8(v[j]);
}
__device__ __forceinline__ void ln_res16_row(bf16_t* xrow, const bf16_t* yrow, const float* __restrict__ gam, const float* __restrict__ bet, int lane) {
    float v[4][8]; u32x4 xw[4], yw[4];
#pragma unroll
    for (int j = 0; j < 4; ++j) { xw[j] = ((const u32x4*)xrow)[lane + 64 * j]; yw[j] = ((const u32x4*)yrow)[lane + 64 * j]; }
#pragma unroll
    for (int j = 0; j < 4; ++j) { float xv[8], yv[8]; unpack8(xw[j], xv); unpack8(yw[j], yv);
#pragma unroll
        for (int e = 0; e < 8; ++e) v[j][e] = xv[e] * ALPHA + yv[e]; }
    ln_core(v, gam, bet, lane);
#pragma unroll
    for (int j = 0; j < 4; ++j) ((u32x4*)xrow)[lane + 64 * j] = pack8(v[j]);
}
__device__ __forceinline__ void ln_res_final16_row(const bf16_t* xrow, const bf16_t* yrow, float* orow, const float* __restrict__ gam, const float* __restrict__ bet, int lane) {
    float v[4][8]; u32x4 xw[4], yw[4];
#pragma unroll
    for (int j = 0; j < 4; ++j) { xw[j] = ((const u32x4*)xrow)[lane + 64 * j]; yw[j] = ((const u32x4*)yrow)[lane + 64 * j]; }
#pragma unroll
    for (int j = 0; j < 4; ++j) { float xv[8], yv[8]; unpack8(xw[j], xv); unpack8(yw[j], yv);
#pragma unroll
        for (int e = 0; e < 8; ++e) v[j][e] = xv[e] * ALPHA + yv[e]; }
    ln_core(v, gam, bet, lane);
#pragma unroll
    for (int j = 0; j < 4; ++j) { f32x4 o0, o1;
#pragma unroll
        for (int e = 0; e < 4; ++e) { o0[e] = v[j][e]; o1[e] = v[j][4 + e]; }
        ((f32x4*)orow)[2 * (lane + 64 * j)] = o0; ((f32x4*)orow)[2 * (lane + 64 * j) + 1] = o1; }
}

__device__ __forceinline__ void attn_phase(LAS unsigned char* lds, bf16_t* B1, const float* __restrict__ rpb, int chunk, int vcu, int G, int tid, int ooff) {
    const int wave = __builtin_amdgcn_readfirstlane(tid >> 6), lane = tid & 63, l15 = lane & 15, g = lane >> 4;
    const int hsel = wave >> 2, cgp = wave & 3;
    const int kapg = 8 * (g & 1) + 4 * (g >> 1); const int kap15 = 8 * ((l15 >> 2) & 1) + 4 * (l15 >> 3) + (l15 & 3);
    const int rows = chunk ? 128 : 256;
    const int nunits = 1024, per = (nunits + G - 1) / G;
    const int sp = (cgp == 0) ? 0 : (cgp == 1) ? 8 : (cgp == 2) ? 24 : 32;
    const int c = 16 * cgp + l15; const int cs = min(max(c - 8, 0), 48);
    const float scale = 0.08838834764831845f;
    LAS float* btab = (LAS float*)(lds + 131072);
    for (int i = tid; i < 8 * 465; i += 512) btab[i] = rpb[i];
    __syncthreads();
    for (int ui = 0; ui < per; ++ui) {
        const int unit = vcu * per + ui; if (unit >= nunits) break;
        const int hp = unit & 3, rowid = unit >> 2, seq = rowid / rows, r = rowid % rows;
        const int h = 2 * hp + hsel;
        const int rs = min(max(r - 4, 0), rows - 8);
        const size_t seqbase = (size_t)seq * rows * 64;
        const bf16_t* qp = B1 + (seqbase + (size_t)r * 64 + c) * B1_LD + Q_OFF + h * 128 + 8 * g;
        bf16x8 qf[4];
#pragma unroll
        for (int s = 0; s < 4; ++s) qf[s] = *(const bf16x8*)(qp + 32 * s);
        f32x4 sacc[16];
#pragma unroll
        for (int kb = 0; kb < 16; ++kb) { const int ir = kb >> 1, hh = kb & 1;
            const bf16_t* kp = B1 + (seqbase + (size_t)(rs + ir) * 64 + sp + 16 * hh + kap15) * B1_LD + K_OFF + h * 128 + 8 * g;
            bf16x8 kf[4];
#pragma unroll
            for (int s = 0; s < 4; ++s) kf[s] = *(const bf16x8*)(kp + 32 * s);
            f32x4 ac = (f32x4){0.f, 0.f, 0.f, 0.f};
#pragma unroll
            for (int s = 0; s < 4; ++s) ac = __builtin_amdgcn_mfma_f32_16x16x32_bf16(kf[s], qf[s], ac, 0, 0, 0);
            sacc[kb] = ac; }
        const LAS float* tb = btab + h * 465;
        float mx = -1e30f;
#pragma unroll
        for (int kb = 0; kb < 16; ++kb) { const int ir = kb >> 1, hh = kb & 1;
#pragma unroll
            for (int i = 0; i < 4; ++i) { const int kc = sp + 16 * hh + kapg + i; const bool valid = (kc >= cs) && (kc < cs + 16);
                int bidx = (rs + ir - r + 7) * 31 + (kc - c + 15); bidx = valid ? bidx : 0;
                const float bias = tb[bidx]; const float sv = valid ? sacc[kb][i] * scale + bias : -1e30f;
                sacc[kb][i] = sv; mx = fmaxf(mx, sv); } }
        mx = fmaxf(mx, __shfl_xor(mx, 16)); mx = fmaxf(mx, __shfl_xor(mx, 32));
        float sum = 0.f;
#pragma unroll
        for (int kb = 0; kb < 16; ++kb)
#pragma unroll
            for (int i = 0; i < 4; ++i) { const float p = __expf(sacc[kb][i] - mx); sum += p; sacc[kb][i] = p; }
        sum += __shfl_xor(sum, 16); sum += __shfl_xor(sum, 32);
        const float inv = 1.0f / sum;
        bf16x8 pf[8];
#pragma unroll
        for (int ks = 0; ks < 8; ++ks) { u32x4 w; w.x = cvt_pk_bf16(sacc[2 * ks][0], sacc[2 * ks][1]); w.y = cvt_pk_bf16(sacc[2 * ks][2], sacc[2 * ks][3]);
            w.z = cvt_pk_bf16(sacc[2 * ks + 1][0], sacc[2 * ks + 1][1]); w.w = cvt_pk_bf16(sacc[2 * ks + 1][2], sacc[2 * ks + 1][3]); pf[ks] = __builtin_bit_cast(bf16x8, w); }
        f32x4 oacc[8];
#pragma unroll
        for (int nb = 0; nb < 8; ++nb) oacc[nb] = (f32x4){0.f, 0.f, 0.f, 0.f};
        const int q4 = l15 >> 2, p4 = l15 & 3;
#pragma unroll
        for (int pass = 0; pass < 2; ++pass) {
            __syncthreads();
#pragma unroll
            for (int b8 = 0; b8 < 2; ++b8) { u32x4 tmp[8];
#pragma unroll
                for (int it = 0; it < 8; ++it) { const int cidx = (b8 * 8 + it) * 512 + tid; const int tk = cidx >> 5, hs = (cidx >> 4) & 1, ch = cidx & 15;
                    tmp[it] = *(const u32x4*)(B1 + (seqbase + (size_t)(rs + 4 * pass) * 64 + tk) * B1_LD + V_OFF + (2 * hp + hs) * 128 + ch * 8); }
#pragma unroll
                for (int it = 0; it < 8; ++it) { const int cidx = (b8 * 8 + it) * 512 + tid; const int tk = cidx >> 5, hs = (cidx >> 4) & 1, ch = cidx & 15;
                    *(LAS u32x4*)(lds + hs * 65536 + 256 * tk + 16 * (ch ^ swz16(tk))) = tmp[it]; } }
            __syncthreads();
            const LAS unsigned char* vb = lds + hsel * 65536;
#pragma unroll
            for (int ksl = 0; ksl < 4; ++ksl) {
                const int row1 = ksl * 64 + sp + kapg + q4, row2 = row1 + 16;
#pragma unroll
                for (int nb = 0; nb < 8; ++nb) { const int ch = 2 * nb + (p4 >> 1);
                    const s16x4 t1 = vtr(vb + 256 * row1 + 16 * (ch ^ swz16(row1)) + 8 * (p4 & 1));
                    const s16x4 t2 = vtr(vb + 256 * row2 + 16 * (ch ^ swz16(row2)) + 8 * (p4 & 1));
                    oacc[nb] = __builtin_amdgcn_mfma_f32_16x16x32_bf16(cat8(t1, t2), pf[pass * 4 + ksl], oacc[nb], 0, 0, 0); } }
        }
        bf16_t* op = B1 + (seqbase + (size_t)r * 64 + c) * B1_LD + ooff + h * 128 + 4 * g;
#pragma unroll
        for (int nb = 0; nb < 8; ++nb) { u32x2 w; w.x = cvt_pk_bf16(oacc[nb][0] * inv, oacc[nb][1] * inv); w.y = cvt_pk_bf16(oacc[nb][2] * inv, oacc[nb][3] * inv); *(u32x2*)(op + 16 * nb) = w; }
    }
    __syncthreads();
}

__device__ __forceinline__ int f_off(int row, int ch) { return 512 * row + 16 * (ch ^ swz16(row)); }

__device__ __forceinline__ void four1_phase(LAS unsigned char* lds, const bf16_t* B1, bf16_t* Z, int chunk, int vcu, int G, int tid) {
    const int wave = __builtin_amdgcn_readfirstlane(tid >> 6), lane = tid & 63, l15 = lane & 15, g = lane >> 4, q4 = l15 >> 2, p4 = l15 & 3;
    const int N2 = chunk ? 64 : 128, nseq = chunk ? 2 : 1, T = 128 * N2;
    const int nunits = nseq * N2 * 4, per = (nunits + G - 1) / G;
    const int k1 = 16 * wave + l15;
    bf16x8 Fc[4], Fs[4];
#pragma unroll
    for (int s = 0; s < 4; ++s) { unsigned wc_[4], ws_[4];
#pragma unroll
        for (int jj = 0; jj < 4; ++jj) { float c0, s0, c1, s1; const int t1a = 32 * s + 8 * g + 2 * jj, t1b = t1a + 1;
            sincospif((float)((k1 * t1a) & 127) * (1.0f / 64.0f), &s0, &c0); sincospif((float)((k1 * t1b) & 127) * (1.0f / 64.0f), &s1, &c1);
            const float sc = 0.08838834764831845f;
            wc_[jj] = cvt_pk_bf16(c0 * sc, c1 * sc); ws_[jj] = cvt_pk_bf16(s0 * sc, s1 * sc); }
        Fc[s] = __builtin_bit_cast(bf16x8, (u32x4){wc_[0], wc_[1], wc_[2], wc_[3]}); Fs[s] = __builtin_bit_cast(bf16x8, (u32x4){ws_[0], ws_[1], ws_[2], ws_[3]}); }
    const int trow0 = tid >> 5, tch = tid & 31;
    u32x4 treg[8];
    if (vcu * per < nunits) { const int unit = vcu * per; const int gq = unit & 3, rest = unit >> 2, t2 = rest % N2, seq = rest / N2;
        const bf16_t* tb = B1 + ((size_t)seq * T + (size_t)trow0 * N2 + t2) * B1_LD + VR_OFF + gq * 256 + tch * 8;
#pragma unroll
        for (int it = 0; it < 8; ++it) treg[it] = *(const u32x4*)(tb + (size_t)it * 16 * N2 * B1_LD); }
    for (int ui = 0; ui < per; ++ui) {
        const int unit = vcu * per + ui; if (unit >= nunits) break;
        const int gq = unit & 3, rest = unit >> 2, t2 = rest % N2, seq = rest / N2;
        const size_t seqbase = (size_t)seq * T;
        __syncthreads();
#pragma unroll
        for (int it = 0; it < 8; ++it) *(LAS u32x4*)(lds + f_off(16 * it + trow0, tch)) = treg[it];
        if (ui + 1 < per && unit + 1 < nunits) { const int un = unit + 1; const int gqn = un & 3, restn = un >> 2, t2n = restn % N2, seqn = restn / N2;
            const bf16_t* tb = B1 + ((size_t)seqn * T + (size_t)trow0 * N2 + t2n) * B1_LD + VR_OFF + gqn * 256 + tch * 8;
#pragma unroll
            for (int it = 0; it < 8; ++it) treg[it] = *(const u32x4*)(tb + (size_t)it * 16 * N2 * B1_LD); }
        __syncthreads();
        float cph, sph; sincospif((float)(k1 * t2) * (2.0f / (float)T), &sph, &cph);
        bf16_t* zrow = Z + (seqbase + (size_t)k1 * N2 + t2) * Z_LD + gq * 512 + 8 * g;
#pragma unroll 2
        for (int nb = 0; nb < 16; ++nb) {
            f32x4 ac = (f32x4){0.f, 0.f, 0.f, 0.f}, as = (f32x4){0.f, 0.f, 0.f, 0.f};
#pragma unroll
            for (int s = 0; s < 4; ++s) { const int r1 = 32 * s + 8 * g + q4, r2 = r1 + 4, ch = 2 * nb + (p4 >> 1);
                const bf16x8 af = cat8(vtr(lds + f_off(r1, ch) + 8 * (p4 & 1)), vtr(lds + f_off(r2, ch) + 8 * (p4 & 1)));
                ac = __builtin_amdgcn_mfma_f32_16x16x32_bf16(af, Fc[s], ac, 0, 0, 0); as = __builtin_amdgcn_mfma_f32_16x16x32_bf16(af, Fs[s], as, 0, 0, 0); }
            u32x4 w;
            w.x = cvt_pk_bf16(ac[0] * cph - as[0] * sph, -as[0] * cph - ac[0] * sph); w.y = cvt_pk_bf16(ac[1] * cph - as[1] * sph, -as[1] * cph - ac[1] * sph);
            w.z = cvt_pk_bf16(ac[2] * cph - as[2] * sph, -as[2] * cph - ac[2] * sph); w.w = cvt_pk_bf16(ac[3] * cph - as[3] * sph, -as[3] * cph - ac[3] * sph);
            *(u32x4*)(zrow + 32 * nb) = w; }
    }
    __syncthreads();
}

__device__ __forceinline__ void four2_phase(LAS unsigned char* lds, const bf16_t* Z, bf16_t* B1, int chunk, int vcu, int G, int tid) {
    const int wave = __builtin_amdgcn_readfirstlane(tid >> 6), lane = tid & 63, l15 = lane & 15, g = lane >> 4, q4 = l15 >> 2, p4 = l15 & 3;
    const int N2 = chunk ? 64 : 128, nseq = chunk ? 2 : 1, T = 128 * N2;
    const int nunits = nseq * 128 * 8, per = (nunits + G - 1) / G;
    const int nkb = N2 >> 4, kb = wave % nkb, npart = wave / nkb, nbn = 16 / (8 / nkb), nsteps = N2 >> 5;
    const int k2 = 16 * kb + l15;
    const float sc = chunk ? 0.125f : 0.08838834764831845f; const float angs = 2.0f / (float)N2;
    bf16x8 Fc[4], Fs[4];
#pragma unroll
    for (int s = 0; s < 4; ++s) { unsigned wc_[4], ws_[4];
#pragma unroll
        for (int jj = 0; jj < 4; ++jj) { float c0, s0, c1, s1; const int ta = 32 * s + 8 * g + 2 * jj, tb = ta + 1;
            sincospif((float)((k2 * ta) & (N2 - 1)) * angs, &s0, &c0); sincospif((float)((k2 * tb) & (N2 - 1)) * angs, &s1, &c1);
            wc_[jj] = cvt_pk_bf16(c0 * sc, c1 * sc); ws_[jj] = cvt_pk_bf16(s0 * sc, s1 * sc); }
        Fc[s] = __builtin_bit_cast(bf16x8, (u32x4){wc_[0], wc_[1], wc_[2], wc_[3]}); Fs[s] = __builtin_bit_cast(bf16x8, (u32x4){ws_[0], ws_[1], ws_[2], ws_[3]}); }
    const int nchunks = N2 * 32 / 512;
    const int trow0 = tid >> 5, tch = tid & 31;
    u32x4 treg[8];
    if (vcu * per < nunits) { const int unit = vcu * per; const int cb = unit & 7, rest = unit >> 3, k1 = rest & 127, seq = rest >> 7;
        const bf16_t* tb = Z + ((size_t)seq * T + (size_t)k1 * N2 + trow0) * Z_LD + cb * 256 + tch * 8;
#pragma unroll
        for (int it = 0; it < 8; ++it) if (it < nchunks) treg[it] = *(const u32x4*)(tb + (size_t)it * 16 * Z_LD); }
    for (int ui = 0; ui < per; ++ui) {
        const int unit = vcu * per + ui; if (unit >= nunits) break;
        const int cb = unit & 7, rest = unit >> 3, k1 = rest & 127, seq = rest >> 7;
        const size_t seqbase = (size_t)seq * T;
        __syncthreads();
#pragma unroll
        for (int it = 0; it < 8; ++it) if (it < nchunks) *(LAS u32x4*)(lds + f_off(16 * it + trow0, tch)) = treg[it];
        if (ui + 1 < per && unit + 1 < nunits) { const int un = unit + 1; const int cbn = un & 7, restn = un >> 3, k1n = restn & 127, seqn = restn >> 7;
            const bf16_t* tb = Z + ((size_t)seqn * T + (size_t)k1n * N2 + trow0) * Z_LD + cbn * 256 + tch * 8;
#pragma unroll
            for (int it = 0; it < 8; ++it) if (it < nchunks) treg[it] = *(const u32x4*)(tb + (size_t)it * 16 * Z_LD); }
        __syncthreads();
        bf16_t* orow = B1 + (seqbase + (size_t)k1 + 128 * (size_t)k2) * B1_LD + cb * 128 + 2 * g;
        for (int nbi = 0; nbi < nbn; ++nbi) { const int nb = npart * nbn + nbi;
            f32x4 pc = (f32x4){0.f, 0.f, 0.f, 0.f}, ps = (f32x4){0.f, 0.f, 0.f, 0.f};
#pragma unroll
            for (int s = 0; s < 4; ++s) { if (s < nsteps) { const int r1 = 32 * s + 8 * g + q4, r2 = r1 + 4, ch = 2 * nb + (p4 >> 1);
                const bf16x8 af = cat8(vtr(lds + f_off(r1, ch) + 8 * (p4 & 1)), vtr(lds + f_off(r2, ch) + 8 * (p4 & 1)));
                pc = __builtin_amdgcn_mfma_f32_16x16x32_bf16(af, Fc[s], pc, 0, 0, 0); ps = __builtin_amdgcn_mfma_f32_16x16x32_bf16(af, Fs[s], ps, 0, 0, 0); } }
            const unsigned vr = cvt_pk_bf16(pc[0] + ps[1], pc[2] + ps[3]), vi = cvt_pk_bf16(pc[1] - ps[0], pc[3] - ps[2]);
            *(unsigned*)(orow + VR_OFF + 8 * nb) = vr; *(unsigned*)(orow + VI_OFF + 8 * nb) = vi; }
    }
    __syncthreads();
}


#define XB_TMO      128
#define XB_XCNT(j)  (256  + 64 * (j))
#define XB_XSUB(j)  (1280 + 64 * (j))
#define XB_XGEN(j)  (2304 + 64 * (j))
#define XB_TOP      3328
#define XB_TOPGEN   3392
#define XCD_BAR_WORDS 3456
#define XB_SPIN_CAP (1u << 18)
__device__ __forceinline__ unsigned xb_ld(unsigned* p)              { return __hip_atomic_load(p, __ATOMIC_RELAXED, __HIP_MEMORY_SCOPE_AGENT); }
__device__ __forceinline__ unsigned xb_add(unsigned* p, unsigned v) { return __hip_atomic_fetch_add(p, v, __ATOMIC_RELAXED, __HIP_MEMORY_SCOPE_AGENT); }
__device__ __forceinline__ unsigned xb_xcc_id() { return (unsigned)__builtin_amdgcn_s_getreg((3 << 11) | 20) & 0xFu; }
#define XB_SPIN(cond, bar) do { unsigned _sp = 0; while (cond) { __builtin_amdgcn_s_sleep(1); \
    if ((++_sp & 255u) == 0u) { if (xb_ld(&(bar)[XB_TMO])) break; if (_sp > XB_SPIN_CAP) { atomicAdd(&(bar)[XB_TMO], 1u); break; } } } } while (0)
struct XcdBarrier { unsigned* bar; unsigned x; volatile LAS unsigned* st; };
__device__ __forceinline__ XcdBarrier xcd_barrier_post(unsigned* bar, volatile LAS unsigned* st) {
    XcdBarrier b; b.bar = bar; b.x = xb_xcc_id(); b.st = st;
    if (threadIdx.x == 0) (void)xb_add(&bar[XB_XCNT(b.x)], 1u);
    return b;
}
__device__ __forceinline__ void xcd_barrier_complete(unsigned* bar, unsigned x, unsigned& nloc, unsigned& nx) {
    const unsigned G = gridDim.x * gridDim.y * gridDim.z;
    unsigned sum, cnt, mine, sp = 0u;
    for (;;) {
        sum = 0u; cnt = 0u; mine = 0u;
#pragma unroll
        for (unsigned j = 0; j < 16; ++j) { const unsigned c = xb_ld(&bar[XB_XCNT(j)]); sum += c; cnt += (c > 0u) ? 1u : 0u; mine = (j == x) ? c : mine; }
        if (sum == G) break;
        __builtin_amdgcn_s_sleep(1);
        if ((++sp & 255u) == 0u) { if (xb_ld(&bar[XB_TMO])) break; if (sp > XB_SPIN_CAP) { atomicAdd(&bar[XB_TMO], 1u); break; } }
    }
    nloc = mine > 0u ? mine : 1u; nx = cnt > 0u ? cnt : 1u;
}
__device__ __forceinline__ void xcd_barrier(const XcdBarrier& b) {
    asm volatile("s_waitcnt vmcnt(0)" ::: "memory");
    __syncthreads();
    if (threadIdx.x == 0) {
        unsigned* bar = b.bar;
        __builtin_amdgcn_s_waitcnt(0);
        unsigned nloc = b.st[0], nx = b.st[1];
        if (nloc == 0u) { xcd_barrier_complete(bar, b.x, nloc, nx); b.st[0] = nloc; b.st[1] = nx; }
        const unsigned old = xb_add(&bar[XB_XSUB(b.x)], 1u);
        const unsigned gen = old / nloc;
        if (old + 1u == (gen + 1u) * nloc) {
            __builtin_amdgcn_fence(__ATOMIC_RELEASE, "agent");
            asm volatile("s_waitcnt vmcnt(0)" ::: "memory");
            const unsigned og = xb_add(&bar[XB_TOP], 1u);
            const unsigned tg = og / nx;
            if (og + 1u == (tg + 1u) * nx) xb_add(&bar[XB_TOPGEN], 1u);
            else XB_SPIN(xb_ld(&bar[XB_TOPGEN]) == tg, bar);
            __builtin_amdgcn_fence(__ATOMIC_ACQUIRE, "agent");
            xb_add(&bar[XB_XGEN(b.x)], 1u);
            asm volatile("s_waitcnt vmcnt(0)" ::: "memory");
        } else {
            XB_SPIN(xb_ld(&bar[XB_XGEN(b.x)]) == gen, bar);
            __builtin_amdgcn_fence(__ATOMIC_ACQUIRE, "agent");
            asm volatile("s_waitcnt vmcnt(0)" ::: "memory");
        }
    }
    __syncthreads();
}

enum { K_P1 = 0, K_ATT = 1, K_F2 = 2, K_P3 = 3, K_P4 = 4, K_LN1 = 5, K_P5 = 6, K_P6 = 7, K_LN2 = 8 };
constexpr int PH_PER_LAYER = 13, N_PHASES = 1 + DEPTH * PH_PER_LAYER;

__global__ void __launch_bounds__(512, 2) fwd_mega(Args a) {
    extern __shared__ __attribute__((aligned(16))) unsigned char lds_raw[];
    LAS unsigned char* lds = (LAS unsigned char*)lds_raw;
    cg::grid_group grid = cg::this_grid();
    const int G0 = gridDim.x, bx0 = blockIdx.x;
    unsigned char* ws = a.ws;
    bf16_t* Bt1 = (bf16_t*)(ws + WS_BT1); bf16_t* Bt3 = (bf16_t*)(ws + WS_BT3); bf16_t* WfT = (bf16_t*)(ws + WS_WFT); bf16_t* Bt4 = (bf16_t*)(ws + WS_BT4);
    bf16_t* Bt5 = (bf16_t*)(ws + WS_BT5); bf16_t* Bt6 = (bf16_t*)(ws + WS_BT6); bf16_t* Tab = (bf16_t*)(ws + WS_TAB);
    bf16_t* XB = (bf16_t*)(ws + WS_XB); bf16_t* B1 = (bf16_t*)(ws + WS_B1); bf16_t* Gt = (bf16_t*)(ws + WS_G); bf16_t* Z = (bf16_t*)(ws + WS_Z); bf16_t* Hb = (bf16_t*)(ws + WS_H);
    bf16_t* YLA = (bf16_t*)(ws + WS_BT1); bf16_t* YLB = (bf16_t*)(ws + WS_YB);
    float* X = a.out; bf16_t* Y16 = (bf16_t*)a.out; bf16_t* MbAll = (bf16_t*)a.out + (size_t)TALL * DM;
    volatile LAS unsigned* bst = (volatile LAS unsigned*)(lds + 147440);
    if (threadIdx.x < 2) bst[threadIdx.x] = 0u;
    __syncthreads();
    const XcdBarrier xbar = xcd_barrier_post((unsigned*)(ws + WS_CTL), bst);

    for (int ph = a.ph_lo; ph < a.ph_hi; ++ph) {
        int tid = threadIdx.x; asm volatile("" : "+v"(tid));
        int G = G0, bx = bx0; asm volatile("" : "+s"(G), "+s"(bx));
        const int vcu = (G % 8 == 0) ? (bx % 8) * (G / 8) + bx / 8 : bx; const int NGW = G * 8;
        const int lane = tid & 63, wave = __builtin_amdgcn_readfirstlane(tid >> 6), gw = vcu * 8 + wave;
        if (ph == 0) {
            wphase(a, 0, lds, gw, NGW, wave, lane);
            for (int m = gw; m < TALL; m += NGW) { const float* src = (m < CHT) ? a.in[0] + (size_t)m * DM : a.in[1] + (size_t)(m - CHT) * DM;
                ln_in_row(src, XB + (size_t)m * DM, a.in[2], a.in[3], lane); }
        } else {
            const int layer = (ph - 1) / PH_PER_LAYER, r = (ph - 1) % PH_PER_LAYER;
            const int chunk = (r < 8) ? r / 4 : 0, kind = (r < 8) ? r % 4 : r - 4;
            if (kind == K_P1) {
                { pg8::Gemm gm{XB + (size_t)chunk * CHT * DM, Bt1, DM, DM, DM}; pg8::StaticOrder S; S.init(CHT, 8192, G, bx);
                  pg8::EpiP1 E{B1, Gt, a.in[9] + (size_t)layer * 4096};
                  pg8::gemm_phase<pg8::EpiP1>(lds, gm, S, E, tid); }
                if (chunk == 0) { pg8::Gemm gm{WfT, Tab, 256, 256, 256}; pg8::StaticOrder S; S.init(8192, 512, G, bx);
                  pg8::EpiFold E{Bt3};
                  pg8::gemm_phase<pg8::EpiFold>(lds, gm, S, E, tid); }
            } else if (kind == K_ATT) {
                attn_phase(lds, B1, a.in[5] + (size_t)layer * 8 * 465, chunk, vcu, G, tid, Q_OFF);
                four1_phase(lds, B1, Z, chunk, vcu, G, tid);
            } else if (kind == K_F2) {
                four2_phase(lds, Z, B1, chunk, vcu, G, tid);
            } else if (kind == K_P3) {
                pg8::Gemm gm{B1, Bt3, B1_LD, 3072, 3072}; pg8::StaticOrder S; S.init(CHT, DM, G, bx);
                pg8::EpiP3 E{Gt, MbAll + (size_t)chunk * CHT * DM};
                pg8::gemm_phase<pg8::EpiP3>(lds, gm, S, E, tid);
            } else if (kind == K_P4) {
                pg8::Gemm gm{MbAll, Bt4, MB_LD, DM, DM}; pg8::StaticOrder S; S.init(TALL, DM, G, bx);
                pg8::EpiY E{Y16, Y16, 1 << 30};
                pg8::gemm_phase<pg8::EpiY>(lds, gm, S, E, tid);
            } else if (kind == K_LN1) {
                const float* gam = a.in[11] + (size_t)layer * DM; const float* bet = a.in[12] + (size_t)layer * DM;
                for (int m = gw; m < TALL; m += NGW) ln_res16_row(XB + (size_t)m * DM, Y16 + (size_t)m * DM, gam, bet, lane);
            } else if (kind == K_P5) {
                pg8::Gemm gm{XB, Bt5, DM, DM, DM}; pg8::StaticOrder S; S.init(TALL, 2 * DFF, G, bx);
                pg8::EpiSwiglu E{Hb};
                pg8::gemm_phase<pg8::EpiSwiglu>(lds, gm, S, E, tid);
            } else if (kind == K_P6) {
                pg8::Gemm gm{Hb, Bt6, H_LD, DFF, DFF}; pg8::StaticOrder S; S.init(TALL, DM, G, bx);
                const pg8::EpiY E = (layer + 1 < DEPTH) ? pg8::EpiY{Y16, Y16, 1 << 30} : pg8::EpiY{YLA, YLB - (size_t)25600 * DM, 100};
                pg8::gemm_phase<pg8::EpiY>(lds, gm, S, E, tid);
            } else {
                const float* gam = a.in[16] + (size_t)layer * DM; const float* bet = a.in[17] + (size_t)layer * DM;
                if (layer + 1 < DEPTH) { for (int m = gw; m < TALL; m += NGW) ln_res16_row(XB + (size_t)m * DM, Y16 + (size_t)m * DM, gam, bet, lane); }
                else { for (int m = gw; m < TALL; m += NGW) ln_res_final16_row(XB + (size_t)m * DM, (m < 25600 ? YLA : YLB - (size_t)25600 * DM) + (size_t)m * DM, X + (size_t)m * DM, gam, bet, lane); }
                if (layer + 1 < DEPTH) wphase(a, layer + 1, lds, gw, NGW, wave, lane);
            }
        }
        if (ph + 1 < a.ph_hi) {
            if (a.ph_hi > (1 << 20)) grid.sync();
            xcd_barrier(xbar);
        }
    }
}

extern "C" void kernel_launch(void* const* d_in, const int* in_sizes, int n_in, void* d_out, int out_size, void* d_ws, size_t ws_size, hipStream_t stream) {
    static int grid = 0;
    if (grid == 0) {
        if (n_in != 18 || out_size != TALL * DM || ws_size < WS_END) { fprintf(stderr, "kernel_launch: unexpected shapes (n_in %d out %d ws %zu, need ws >= %zu)\n", n_in, out_size, ws_size, (size_t)WS_END); grid = -1; return; }
        int dev = 0, cus = 0, per_cu = 0;
        hipGetDevice(&dev); hipDeviceGetAttribute(&cus, hipDeviceAttributeMultiprocessorCount, dev);
        if (hipFuncSetAttribute((const void*)fwd_mega, hipFuncAttributeMaxDynamicSharedMemorySize, LDS_BYTES) != hipSuccess) { fprintf(stderr, "kernel_launch: hipFuncSetAttribute failed\n"); grid = -1; return; }
        if (hipOccupancyMaxActiveBlocksPerMultiprocessor(&per_cu, (const void*)fwd_mega, 512, LDS_BYTES) != hipSuccess || per_cu < 1) { fprintf(stderr, "kernel_launch: occupancy query says %d\n", per_cu); per_cu = 1; }
        (void)hipGetLastError();
        grid = cus * 1;
    }
    if (grid < 0) return;
    if (hipMemsetAsync((char*)d_ws + WS_CTL, 0, 65536, stream) != hipSuccess) { fprintf(stderr, "kernel_launch: memset failed\n"); return; }
    Args a{};
    for (int i = 0; i < 18; ++i) a.in[i] = (const float*)d_in[i];
    a.out = (float*)d_out; a.ws = (unsigned char*)d_ws;
#if MK_PER_PHASE
    for (int ph = 0; ph < N_PHASES; ++ph) { a.ph_lo = ph; a.ph_hi = ph + 1; hipLaunchKernelGGL(fwd_mega, dim3(grid), dim3(512), LDS_BYTES, stream, a); }
#else
    a.ph_lo = 0; a.ph_hi = N_PHASES;
    void* args[] = {&a};
    hipError_t e = hipLaunchCooperativeKernel((const void*)fwd_mega, dim3(grid), dim3(512), args, LDS_BYTES, stream);
    if (e != hipSuccess) fprintf(stderr, "cooperative launch failed: %s (grid %d)\n", hipGetErrorString(e), grid);
#endif
}
```

```cpp
#include <hip/hip_runtime.h>
#include <hip/hip_cooperative_groups.h>
#include <cstdio>
#include <cstdint>
namespace cg = cooperative_groups;

#define LAS __attribute__((address_space(3)))
typedef unsigned short bf16_t;
typedef short bf16x8 __attribute__((ext_vector_type(8)));
typedef short s16x4 __attribute__((ext_vector_type(4)));
typedef float f32x4 __attribute__((ext_vector_type(4)));
typedef float f32x2 __attribute__((ext_vector_type(2)));
typedef unsigned u32x4 __attribute__((ext_vector_type(4)));
typedef unsigned u32x2 __attribute__((ext_vector_type(2)));

#ifndef MK_PER_PHASE
#define MK_PER_PHASE 0
#endif

constexpr int DM = 2048, TALL = 32768, CHT = 16384, DEPTH = 2, DFF = 5632;
constexpr int B1_LD = 5120, Q_OFF = 0, VR_OFF = 1024, VI_OFF = 2048, K_OFF = 3072, V_OFF = 4096;
constexpr int G_LD = 4096, Z_LD = 2048, MB_LD = 2048, H_LD = 5632;
constexpr float LN_EPS = 1e-5f;
constexpr float ALPHA = 1.41421356237309515f;

constexpr size_t MiB = 1u << 20;
constexpr size_t WS_BT1 = 0, WS_BT3 = 32 * MiB, WS_WFT = 44 * MiB, WS_BT4 = 48 * MiB, WS_BT5 = 56 * MiB, WS_BT6 = 100 * MiB, WS_TAB = 122 * MiB;
constexpr size_t WS_XB = 124 * MiB, WS_R = 252 * MiB, WS_B1 = WS_R, WS_G = WS_R + 160 * MiB, WS_Z = WS_R + 288 * MiB, WS_H = WS_R, WS_CTL = WS_R + 352 * MiB, WS_YB = WS_CTL + 1 * MiB, WS_END = WS_YB + 28 * MiB;
constexpr int LDS_BYTES = 147456;

typedef __bf16 bf16x2_t __attribute__((ext_vector_type(2)));
__device__ __forceinline__ unsigned cvt_pk_bf16(float lo, float hi) { const f32x2 v = {lo, hi}; const bf16x2_t b = __builtin_convertvector(v, bf16x2_t); return __builtin_bit_cast(unsigned, b); }
__device__ __forceinline__ float bf_lo(unsigned w) { return __uint_as_float(w << 16); }
__device__ __forceinline__ float bf_hi(unsigned w) { return __uint_as_float(w & 0xffff0000u); }
__device__ __forceinline__ float rcpf_(float x) { return __builtin_amdgcn_rcpf(x); }
__device__ __forceinline__ float sigmoidf_(float x) { return rcpf_(1.0f + __builtin_amdgcn_exp2f(x * -1.4426950408889634f)); }

namespace pg8 {
constexpr int BM = 256, BK = 64, HALF = 128, HTB = HALF * BK * 2, STAGE_BYTES = 8 * HTB, NXCD = 8, WGM = 8;
__host__ __device__ __forceinline__ int lds_byte(int r, int c) { const int st = (r >> 4) * 2 + (c >> 5), rr = r & 15, cc = c & 31, ob = rr * 64 + cc * 2; return st * 1024 + (ob ^ (((ob >> 9) & 1) << 5)); }
__host__ __device__ __forceinline__ void stage_rc(int b, int& R, int& C) { const int st = b / 1024, sb = b % 1024, swz = sb ^ (((sb >> 9) & 1) << 5); R = (st >> 1) * 16 + swz / 64; C = (st & 1) * 32 + (swz % 64) / 2; }
__host__ __device__ __forceinline__ int perm32(int rho) { const int n = rho >> 4, i = rho & 15; return 8 * (i >> 2) + 4 * n + (i & 3); }

struct Unit { int pm, pn; };
struct Gemm { const bf16_t* A; const bf16_t* Bt; int lda, ldb, K; };

struct StaticOrder {
    int nM, nN, nwg, G, c;
    __host__ __device__ void init(int M, int N, int G_, int c_) { nM = M / BM; nN = N / BM; nwg = nM * nN; G = G_; c = c_; }
    __host__ __device__ bool next(int i, Unit& u) const {
        const long L = (long)i * G + c; if (L >= nwg) return false;
        int wgid = (int)L; { const int q = nwg / NXCD, r = nwg % NXCD, xcd = wgid % NXCD, off = wgid / NXCD; wgid = (xcd < r ? xcd * (q + 1) : r * (q + 1) + (xcd - r) * q) + off; }
        const int nig = WGM * nN, gid = wgid / nig, fm = gid * WGM, gsz = (nM - fm) < WGM ? (nM - fm) : WGM;
        u.pm = fm + ((wgid % nig) % gsz); u.pn = (wgid % nig) / gsz; return true;
    }
};

typedef f32x4 Acc[2][2][4][2];

struct EpiP1 {
    static constexpr bool PERM = true; static constexpr int MID_T = -1;
    bf16_t* B1; bf16_t* G; const float* bgate;
    __device__ __forceinline__ void mid(Acc&, const Unit&, int, int, int, int) const {}
    __device__ __forceinline__ void operator()(const Acc& acc, const Unit& u, int wr, int wc, int fr, int fq) const {
        const int row0 = u.pm * BM + wr * 64 + fr; const int ct = u.pn;
        if (ct < 16) {
            const int seg = ct >> 2;
            const int coff = (seg == 0 ? Q_OFF : seg == 1 ? K_OFF : seg == 2 ? V_OFF : VR_OFF) + (ct & 3) * 256 + wc * 32 + 8 * fq;
#pragma unroll
            for (int ai = 0; ai < 2; ++ai)
#pragma unroll
                for (int m = 0; m < 4; ++m) { bf16_t* rowp = B1 + (size_t)(row0 + ai * HALF + m * 16) * B1_LD + coff;
#pragma unroll
                    for (int bj = 0; bj < 2; ++bj) { const f32x4 v0 = acc[ai][bj][m][0], v1 = acc[ai][bj][m][1];
                        u32x4 w; w.x = cvt_pk_bf16(v0[0], v0[1]); w.y = cvt_pk_bf16(v0[2], v0[3]); w.z = cvt_pk_bf16(v1[0], v1[1]); w.w = cvt_pk_bf16(v1[2], v1[3]);
                        *(u32x4*)(rowp + bj * HALF) = w; } }
        } else {
            const int gcol0 = (ct - 16) * HALF + wc * 32 + 8 * fq;
            f32x4 ba[2], bf[2];
#pragma unroll
            for (int n = 0; n < 2; ++n) { ba[n] = *(const f32x4*)(bgate + gcol0 + 4 * n); bf[n] = *(const f32x4*)(bgate + DM + gcol0 + 4 * n); }
#pragma unroll
            for (int ai = 0; ai < 2; ++ai)
#pragma unroll
                for (int m = 0; m < 4; ++m) { bf16_t* rowp = G + (size_t)(row0 + ai * HALF + m * 16) * G_LD + gcol0;
                    f32x4 rr[2], gg[2];
#pragma unroll
                    for (int n = 0; n < 2; ++n) { const f32x4 va = acc[ai][0][m][n] + ba[n], vf = acc[ai][1][m][n] + bf[n];
#pragma unroll
                        for (int j = 0; j < 4; ++j) { const float ea = __builtin_amdgcn_exp2f(va[j] * -1.4426950408889634f), ef = __builtin_amdgcn_exp2f(vf[j] * -1.4426950408889634f);
                            gg[n][j] = rcpf_(1.0f + ef); rr[n][j] = (1.0f + ef) * rcpf_(1.0f + ea); } }
                    u32x4 w; w.x = cvt_pk_bf16(rr[0][0], rr[0][1]); w.y = cvt_pk_bf16(rr[0][2], rr[0][3]); w.z = cvt_pk_bf16(rr[1][0], rr[1][1]); w.w = cvt_pk_bf16(rr[1][2], rr[1][3]);
                    *(u32x4*)rowp = w;
                    u32x4 v; v.x = cvt_pk_bf16(gg[0][0], gg[0][1]); v.y = cvt_pk_bf16(gg[0][2], gg[0][3]); v.z = cvt_pk_bf16(gg[1][0], gg[1][1]); v.w = cvt_pk_bf16(gg[1][2], gg[1][3]);
                    *(u32x4*)(rowp + DM) = v; }
        }
    }
};

struct EpiP3 {
    static constexpr bool PERM = true; static constexpr int MID_T = 16;
    const bf16_t* __restrict__ G; bf16_t* __restrict__ Mb;
    __device__ __forceinline__ void mid(Acc& acc, const Unit& u, int wr, int wc, int fr, int fq) const {
        asm volatile("" : "+v"(fr), "+v"(fq));
        const int row0 = u.pm * BM + wr * 64 + fr, col0 = u.pn * BM + wc * 32 + 8 * fq;
#pragma unroll
        for (int ai = 0; ai < 2; ++ai) {
            u32x4 rr[4][2];
#pragma unroll
            for (int m = 0; m < 4; ++m)
#pragma unroll
                for (int bj = 0; bj < 2; ++bj) rr[m][bj] = *(const u32x4*)(G + (size_t)(row0 + ai * HALF + m * 16) * G_LD + col0 + bj * HALF);
#pragma unroll
            for (int m = 0; m < 4; ++m)
#pragma unroll
                for (int bj = 0; bj < 2; ++bj) { const u32x4 a = rr[m][bj]; f32x4 r0, r1;
                    r0[0] = bf_lo(a.x); r0[1] = bf_hi(a.x); r0[2] = bf_lo(a.y); r0[3] = bf_hi(a.y); r1[0] = bf_lo(a.z); r1[1] = bf_hi(a.z); r1[2] = bf_lo(a.w); r1[3] = bf_hi(a.w);
                    acc[ai][bj][m][0] *= r0; acc[ai][bj][m][1] *= r1; }
            asm volatile("" ::: "memory"); }
    }
    __device__ __forceinline__ void operator()(const Acc& acc, const Unit& u, int wr, int wc, int fr, int fq) const {
        const int row0 = u.pm * BM + wr * 64 + fr, col0 = u.pn * BM + wc * 32 + 8 * fq;
#pragma unroll
        for (int ai = 0; ai < 2; ++ai) {
            u32x4 gf[4][2];
#pragma unroll
            for (int m = 0; m < 4; ++m)
#pragma unroll
                for (int bj = 0; bj < 2; ++bj) gf[m][bj] = *(const u32x4*)(G + (size_t)(row0 + ai * HALF + m * 16) * G_LD + DM + col0 + bj * HALF);
#pragma unroll
            for (int m = 0; m < 4; ++m)
#pragma unroll
                for (int bj = 0; bj < 2; ++bj) { const u32x4 f = gf[m][bj]; const f32x4 v0 = acc[ai][bj][m][0], v1 = acc[ai][bj][m][1];
                    u32x4 w; w.x = cvt_pk_bf16(v0[0] * bf_lo(f.x), v0[1] * bf_hi(f.x)); w.y = cvt_pk_bf16(v0[2] * bf_lo(f.y), v0[3] * bf_hi(f.y));
                    w.z = cvt_pk_bf16(v1[0] * bf_lo(f.z), v1[1] * bf_hi(f.z)); w.w = cvt_pk_bf16(v1[2] * bf_lo(f.w), v1[3] * bf_hi(f.w));
                    *(u32x4*)(Mb + (size_t)(row0 + ai * HALF + m * 16) * MB_LD + col0 + bj * HALF) = w; }
            asm volatile("" ::: "memory"); }
    }
};

struct EpiY {
    static constexpr bool PERM = true; static constexpr int MID_T = -1;
    bf16_t* Y; bf16_t* Y2; int split;
    __device__ __forceinline__ void mid(Acc&, const Unit&, int, int, int, int) const {}
    __device__ __forceinline__ void operator()(const Acc& acc, const Unit& u, int wr, int wc, int fr, int fq) const {
        const int row0 = u.pm * BM + wr * 64 + fr, col0 = u.pn * BM + wc * 32 + 8 * fq;
        bf16_t* Yb = (u.pm < split) ? Y : Y2;
#pragma unroll
        for (int ai = 0; ai < 2; ++ai)
#pragma unroll
            for (int m = 0; m < 4; ++m) { bf16_t* rowp = Yb + (size_t)(row0 + ai * HALF + m * 16) * DM + col0;
#pragma unroll
                for (int bj = 0; bj < 2; ++bj) { const f32x4 v0 = acc[ai][bj][m][0], v1 = acc[ai][bj][m][1];
                    u32x4 w; w.x = cvt_pk_bf16(v0[0], v0[1]); w.y = cvt_pk_bf16(v0[2], v0[3]); w.z = cvt_pk_bf16(v1[0], v1[1]); w.w = cvt_pk_bf16(v1[2], v1[3]);
                    *(u32x4*)(rowp + bj * HALF) = w; } }
    }
};

struct EpiSwiglu {
    static constexpr bool PERM = true; static constexpr int MID_T = -1;
    bf16_t* H;
    __device__ __forceinline__ void mid(Acc&, const Unit&, int, int, int, int) const {}
    __device__ __forceinline__ void operator()(const Acc& acc, const Unit& u, int wr, int wc, int fr, int fq) const {
        const int row0 = u.pm * BM + wr * 64 + fr, col0 = u.pn * HALF + wc * 32 + 8 * fq;
#pragma unroll
        for (int ai = 0; ai < 2; ++ai)
#pragma unroll
            for (int m = 0; m < 4; ++m) { bf16_t* rowp = H + (size_t)(row0 + ai * HALF + m * 16) * H_LD + col0;
                f32x4 o0, o1;
#pragma unroll
                for (int j = 0; j < 4; ++j) { const float g0 = acc[ai][0][m][0][j], g1 = acc[ai][0][m][1][j];
                    o0[j] = g0 * sigmoidf_(g0) * acc[ai][1][m][0][j]; o1[j] = g1 * sigmoidf_(g1) * acc[ai][1][m][1][j]; }
                u32x4 w; w.x = cvt_pk_bf16(o0[0], o0[1]); w.y = cvt_pk_bf16(o0[2], o0[3]); w.z = cvt_pk_bf16(o1[0], o1[1]); w.w = cvt_pk_bf16(o1[2], o1[3]);
                *(u32x4*)rowp = w; }
    }
};

struct EpiFold {
    static constexpr bool PERM = true; static constexpr int MID_T = -1;
    bf16_t* Bt3;
    __device__ __forceinline__ void mid(Acc&, const Unit&, int, int, int, int) const {}
    __device__ __forceinline__ void operator()(const Acc& acc, const Unit& u, int wr, int wc, int fr, int fq) const {
        const int g = u.pm >> 3, d0 = (u.pm & 7) * 256 + wr * 64 + fr, col0 = 1024 + u.pn * 1024 + g * 256 + wc * 32 + 8 * fq;
#pragma unroll
        for (int ai = 0; ai < 2; ++ai)
#pragma unroll
            for (int m = 0; m < 4; ++m) { bf16_t* rowp = Bt3 + (size_t)(d0 + ai * HALF + m * 16) * 3072 + col0;
#pragma unroll
                for (int bj = 0; bj < 2; ++bj) { const f32x4 v0 = acc[ai][bj][m][0], v1 = acc[ai][bj][m][1];
                    u32x4 w; w.x = cvt_pk_bf16(v0[0], v0[1]); w.y = cvt_pk_bf16(v0[2], v0[3]); w.z = cvt_pk_bf16(v1[0], v1[1]); w.w = cvt_pk_bf16(v1[2], v1[3]);
                    *(u32x4*)(rowp + bj * HALF) = w; } }
    }
};

template <class Epi, bool ALIGN_EPI = true>
__device__ __forceinline__ void gemm_phase(LAS unsigned char* lds, const Gemm g, const StaticOrder& S, const Epi& E, const int tid) {
    const int wid = __builtin_amdgcn_readfirstlane(tid >> 6), lane = tid & 63, wr = wid >> 2, wc = wid & 3, fr = lane & 15, fq = lane >> 4;
    const int K = g.K; int nt = K / BK; asm volatile("" : "+s"(nt));
    unsigned voffA[2], voffB[2];
#pragma unroll
    for (int i = 0; i < 2; ++i) { int R, C; stage_rc(tid * 16 + i * 8192, R, C); const int Rb = Epi::PERM ? ((R & ~31) + perm32(R & 31)) : R;
        voffA[i] = (unsigned)(R * g.lda + C) * 2u; voffB[i] = (unsigned)(Rb * g.ldb + C) * 2u; }
    const size_t kstep = (size_t)(BK * 2);
    const size_t hA = (size_t)HALF * g.lda * 2, hB = (size_t)HALF * g.ldb * 2;
    const size_t tA = 2 * hA, tB = 2 * hB;
    const unsigned ldsw = (unsigned)wid * 1024u;
    const int aoff = lds_byte(wr * 64 + fr, fq * 8), boff = lds_byte(wc * 32 + fr, fq * 8);
#define PG8_SA(b, h) (((b) * 2 + (h)) * HTB)
#define PG8_SB(b, h) ((4 + (b) * 2 + (h)) * HTB)
#define PG8_STAGE(bufoff, gbase, voff) do { _Pragma("unroll") for (int _i = 0; _i < 2; ++_i) \
        __builtin_amdgcn_global_load_lds((const unsigned*)((const char*)(gbase) + (voff)[_i]), (LAS unsigned*)(lds + (bufoff) + ldsw + _i * 8192), 16, 0, 0); } while (0)
#define PG8_LDA(dst, b, h) do { _Pragma("unroll") for (int m = 0; m < 4; ++m) _Pragma("unroll") for (int k = 0; k < 2; ++k) dst[m][k] = *(const LAS bf16x8*)(lds + PG8_SA(b, h) + aoff + m * 2048 + k * 1024); } while (0)
#define PG8_LDB(dst, b, h) do { _Pragma("unroll") for (int n = 0; n < 2; ++n) _Pragma("unroll") for (int k = 0; k < 2; ++k) dst[n][k] = *(const LAS bf16x8*)(lds + PG8_SB(b, h) + boff + n * 2048 + k * 1024); } while (0)
#define PG8_MMA(ai, bj, At, Bt) do { __builtin_amdgcn_s_setprio(1); _Pragma("unroll") for (int m = 0; m < 4; ++m) _Pragma("unroll") for (int n = 0; n < 2; ++n) _Pragma("unroll") for (int k = 0; k < 2; ++k) \
        acc[ai][bj][m][n] = __builtin_amdgcn_mfma_f32_16x16x32_bf16(Bt[n][k], At[m][k], acc[ai][bj][m][n], 0, 0, 0); __builtin_amdgcn_s_setprio(0); } while (0)
#define PG8_WAIT_V(n) asm volatile("s_waitcnt vmcnt(" #n ")" ::: "memory")
#define PG8_WAIT_L(n) asm volatile("s_waitcnt lgkmcnt(" #n ")" ::: "memory")
#define PG8_BAR __builtin_amdgcn_s_barrier()
#define PG8_SCHED __builtin_amdgcn_sched_barrier(0)
    Unit cur, nxt; int ui = 0;
    if (!S.next(0, cur)) return;
    Acc acc;
#pragma unroll
    for (int a = 0; a < 2; ++a)
#pragma unroll
        for (int b = 0; b < 2; ++b)
#pragma unroll
            for (int m = 0; m < 4; ++m)
#pragma unroll
                for (int n = 0; n < 2; ++n) acc[a][b][m][n] = (f32x4){0.f, 0.f, 0.f, 0.f};
    bf16x8 At[4][2], B0[2][2], B1[2][2];
    const char* cA = (const char*)g.A + (size_t)cur.pm * tA; const char* cB = (const char*)g.Bt + (size_t)cur.pn * tB;
    PG8_STAGE(PG8_SB(0, 0), cB, voffB); PG8_STAGE(PG8_SB(0, 1), cB + hB, voffB); PG8_STAGE(PG8_SA(0, 0), cA, voffA); PG8_STAGE(PG8_SA(0, 1), cA + hA, voffA);
    if (wr == 1) PG8_BAR;
    PG8_WAIT_V(2); PG8_BAR;
    PG8_STAGE(PG8_SB(1, 0), cB + kstep, voffB); PG8_STAGE(PG8_SA(1, 0), cA + kstep, voffA); PG8_STAGE(PG8_SB(1, 1), cB + hB + kstep, voffB);
    PG8_WAIT_V(6); PG8_BAR;
    for (;;) {
        const bool has_next = S.next(ui + 1, nxt);
        const char* nA = has_next ? (const char*)g.A + (size_t)nxt.pm * tA : cA; const char* nB = has_next ? (const char*)g.Bt + (size_t)nxt.pn * tB : cB;
        for (int t = 0; t < nt; t += 2) {
            const bool last = (t == nt - 2);
            const char* a1 = cA + (size_t)(t + 1) * kstep;
            const char* a2 = last ? nA : cA + (size_t)(t + 2) * kstep; const char* b2 = last ? nB : cB + (size_t)(t + 2) * kstep;
            const char* a3 = a2 + kstep; const char* b3 = b2 + kstep;
            if constexpr (Epi::MID_T >= 0) { if (t == Epi::MID_T) { E.mid(acc, cur, wr, wc, fr, fq); PG8_SCHED; } }
            PG8_LDB(B0, 0, 0); PG8_LDB(B1, 0, 1); PG8_SCHED; PG8_LDA(At, 0, 0); PG8_STAGE(PG8_SA(1, 1), a1 + hA, voffA);
            PG8_WAIT_V(8); PG8_WAIT_L(0); PG8_BAR; PG8_MMA(0, 0, At, B0); PG8_MMA(0, 1, At, B1); PG8_BAR; PG8_SCHED;
            PG8_LDA(At, 0, 1); PG8_STAGE(PG8_SB(0, 0), b2, voffB); PG8_STAGE(PG8_SB(0, 1), b2 + hB, voffB); PG8_STAGE(PG8_SA(0, 0), a2, voffA);
            PG8_WAIT_V(8); PG8_WAIT_L(0); PG8_BAR; PG8_MMA(1, 0, At, B0); PG8_MMA(1, 1, At, B1); PG8_BAR; PG8_SCHED;
            PG8_LDB(B0, 1, 0); PG8_LDB(B1, 1, 1); PG8_SCHED; PG8_LDA(At, 1, 0); PG8_STAGE(PG8_SA(0, 1), a2 + hA, voffA);
            PG8_WAIT_V(8); PG8_WAIT_L(0); PG8_BAR; PG8_MMA(0, 0, At, B0); PG8_MMA(0, 1, At, B1); PG8_BAR; PG8_SCHED;
            PG8_LDA(At, 1, 1); PG8_STAGE(PG8_SB(1, 0), b3, voffB); PG8_STAGE(PG8_SB(1, 1), b3 + hB, voffB); PG8_STAGE(PG8_SA(1, 0), a3, voffA);
            PG8_WAIT_V(8); PG8_WAIT_L(0); PG8_BAR; PG8_MMA(1, 0, At, B0); PG8_MMA(1, 1, At, B1); PG8_BAR; PG8_SCHED;
        }
        if constexpr (ALIGN_EPI) { if (wr == 0) PG8_BAR; }
        E(acc, cur, wr, wc, fr, fq);
        if (!has_next) break;
#pragma unroll
        for (int a = 0; a < 2; ++a)
#pragma unroll
            for (int b = 0; b < 2; ++b)
#pragma unroll
                for (int m = 0; m < 4; ++m)
#pragma unroll
                    for (int n = 0; n < 2; ++n) acc[a][b][m][n] = (f32x4){0.f, 0.f, 0.f, 0.f};
        cur = nxt; cA = nA; cB = nB; ++ui;
        if constexpr (ALIGN_EPI) { if (wr == 1) PG8_BAR; }
    }
    PG8_WAIT_V(0);
    if constexpr (!ALIGN_EPI) { if (wr == 0) PG8_BAR; }
    PG8_BAR;
#undef PG8_SA
#undef PG8_SB
#undef PG8_STAGE
#undef PG8_LDA
#undef PG8_LDB
#undef PG8_MMA
#undef PG8_WAIT_V
#undef PG8_WAIT_L
#undef PG8_BAR
#undef PG8_SCHED
}
}

#define LDS_WAIT() asm volatile("s_waitcnt lgkmcnt(0)" ::: "memory")
__device__ __forceinline__ float wave_sum(float v) {
#pragma unroll
    for (int o = 1; o < 64; o <<= 1) v += __shfl_xor(v, o);
    return v;
}
__device__ __forceinline__ s16x4 vtr(const LAS unsigned char* p) { return __builtin_bit_cast(s16x4, __builtin_amdgcn_ds_read_tr16_b64_v4i16((LAS s16x4*)p)); }
__device__ __forceinline__ bf16x8 cat8(s16x4 a, s16x4 b) { bf16x8 r; r[0] = a[0]; r[1] = a[1]; r[2] = a[2]; r[3] = a[3]; r[4] = b[0]; r[5] = b[1]; r[6] = b[2]; r[7] = b[3]; return r; }
__device__ __forceinline__ int swz16(int row) { return ((row & 3) << 2) | ((row >> 2) & 3); }

struct Args {
    const float* in[18]; float* out; unsigned char* ws; int ph_lo, ph_hi;
};

__device__ __forceinline__ void transpose_item(const float* __restrict__ W, int ldw, int k0, int n0, bf16_t* WT, int ldo, int drow0, int dcol0, LAS float* scr, int lane) {
    float t32[32];
#pragma unroll
    for (int i = 0; i < 32; ++i) { const int kk = 2 * i + (lane >> 5); t32[i] = __builtin_nontemporal_load(&W[(size_t)(k0 + kk) * ldw + n0 + (lane & 31)]); }
#pragma unroll
    for (int i = 0; i < 32; ++i) { const int kk = 2 * i + (lane >> 5); scr[kk * 33 + (lane & 31)] = t32[i]; }
    LDS_WAIT(); asm volatile("" ::: "memory");
    const int c = lane & 7;
#pragma unroll
    for (int j = 0; j < 4; ++j) { const int n = (lane >> 3) + 8 * j; const LAS float* s = scr + (8 * c) * 33 + n;
        u32x4 o; o.x = cvt_pk_bf16(s[0 * 33], s[1 * 33]); o.y = cvt_pk_bf16(s[2 * 33], s[3 * 33]); o.z = cvt_pk_bf16(s[4 * 33], s[5 * 33]); o.w = cvt_pk_bf16(s[6 * 33], s[7 * 33]);
        *(u32x4*)(WT + (size_t)(drow0 + n) * ldo + dcol0 + 8 * c) = o; }
    LDS_WAIT(); asm volatile("" ::: "memory");
}

__device__ __forceinline__ void wphase(const Args& a, int layer, LAS unsigned char* lds, int gw, int NGW, int wave, int lane) {
    unsigned char* ws = a.ws;
    bf16_t* Bt1 = (bf16_t*)(ws + WS_BT1); bf16_t* Bt3 = (bf16_t*)(ws + WS_BT3); bf16_t* WfT = (bf16_t*)(ws + WS_WFT); bf16_t* Bt4 = (bf16_t*)(ws + WS_BT4);
    bf16_t* Bt5 = (bf16_t*)(ws + WS_BT5); bf16_t* Bt6 = (bf16_t*)(ws + WS_BT6); bf16_t* Tab = (bf16_t*)(ws + WS_TAB);
    const float* w_in = a.in[4] + (size_t)layer * DM * 4096; const float* w_att = a.in[6] + (size_t)layer * 1024 * DM; const float* w_four = a.in[7] + (size_t)layer * 1024 * DM;
    const float* w_gate = a.in[8] + (size_t)layer * DM * 4096; const float* w_out = a.in[10] + (size_t)layer * DM * DM;
    const float* w_fg = a.in[13] + (size_t)layer * DM * DFF; const float* w_fu = a.in[14] + (size_t)layer * DM * DFF; const float* w_fd = a.in[15] + (size_t)layer * DFF * DM;
    LAS float* scr = (LAS float*)(lds + wave * 16384);
    constexpr int I_IN = 32 * 128, I_ATT = 16 * 64, I_OUT = 32 * 64, I_FF = 32 * 176, I_FD = 88 * 64;
    constexpr int NITEMS = 2 * I_IN + 2 * I_ATT + I_OUT + 2 * I_FF + I_FD;
    for (int it = gw; it < NITEMS; it += NGW) {
        int r = it;
        if (r < I_IN) { const int kb = r / 128, nb = r % 128; transpose_item(w_in, 4096, 64 * kb, 32 * nb, Bt1, DM, 32 * nb, 64 * kb, scr, lane); continue; } r -= I_IN;
        if (r < I_IN) { const int kb = r / 128, nb = r % 128; const int n0 = 32 * nb, jj = n0 & 2047; transpose_item(w_gate, 4096, 64 * kb, n0, Bt1, DM, 4096 + 256 * (jj >> 7) + 128 * (n0 >> 11) + (jj & 127), 64 * kb, scr, lane); continue; } r -= I_IN;
        if (r < I_ATT) { const int kb = r / 64, nb = r % 64; transpose_item(w_att, DM, 64 * kb, 32 * nb, Bt3, 3072, 32 * nb, 64 * kb, scr, lane); continue; } r -= I_ATT;
        if (r < I_ATT) { const int kb = r / 64, nb = r % 64; const int k0 = 64 * kb; transpose_item(w_four, DM, k0, 32 * nb, WfT, 256, (k0 >> 8) * 2048 + 32 * nb, k0 & 255, scr, lane); continue; } r -= I_ATT;
        if (r < I_OUT) { const int kb = r / 64, nb = r % 64; transpose_item(w_out, DM, 64 * kb, 32 * nb, Bt4, DM, 32 * nb, 64 * kb, scr, lane); continue; } r -= I_OUT;
        if (r < I_FF) { const int kb = r / 176, nb = r % 176; const int n0 = 32 * nb; transpose_item(w_fg, DFF, 64 * kb, n0, Bt5, DM, 256 * (n0 >> 7) + (n0 & 127), 64 * kb, scr, lane); continue; } r -= I_FF;
        if (r < I_FF) { const int kb = r / 176, nb = r % 176; const int n0 = 32 * nb; transpose_item(w_fu, DFF, 64 * kb, n0, Bt5, DM, 256 * (n0 >> 7) + 128 + (n0 & 127), 64 * kb, scr, lane); continue; } r -= I_FF;
        { const int kb = r / 64, nb = r % 64; transpose_item(w_fd, DM, 64 * kb, 32 * nb, Bt6, DFF, 32 * nb, 64 * kb, scr, lane); }
    }
    for (int e = gw * 64 + lane; e < 512 * 256; e += NGW * 64) { const int kc = e & 255, c = (e >> 8) & 255, cs = e >> 16;
        float sv, cv; sincospif((float)((c * kc) & 255) * (1.0f / 128.0f), &sv, &cv); const float v = (cs ? sv : cv) * 0.0625f;
        Tab[e] = (bf16_t)(cvt_pk_bf16(v, 0.f) & 0xffffu); }
}

__device__ __forceinline__ void unpack8(const u32x4 w, float* v) { v[0] = bf_lo(w.x); v[1] = bf_hi(w.x); v[2] = bf_lo(w.y); v[3] = bf_hi(w.y); v[4] = bf_lo(w.z); v[5] = bf_hi(w.z); v[6] = bf_lo(w.w); v[7] = bf_hi(w.w); }
__device__ __forceinline__ void ln_core(float (&v)[4][8], const float* __restrict__ gam, const float* __restrict__ bet, int lane) {
    float s = 0.f;
#pragma unroll
    for (int j = 0; j < 4; ++j)
#pragma unroll
        for (int e = 0; e < 8; ++e) s += v[j][e];
    const float mean = wave_sum(s) * (1.f / DM); float s2 = 0.f;
#pragma unroll
    for (int j = 0; j < 4; ++j)
#pragma unroll
        for (int e = 0; e < 8; ++e) { v[j][e] -= mean; s2 += v[j][e] * v[j][e]; }
    const float rstd = 1.f / sqrtf(wave_sum(s2) * (1.f / DM) + LN_EPS);
#pragma unroll
    for (int j = 0; j < 4; ++j) { const f32x4 g0 = ((const f32x4*)gam)[2 * (lane + 64 * j)], g1 = ((const f32x4*)gam)[2 * (lane + 64 * j) + 1];
        const f32x4 b0 = ((const f32x4*)bet)[2 * (lane + 64 * j)], b1 = ((const f32x4*)bet)[2 * (lane + 64 * j) + 1];
#pragma unroll
        for (int e = 0; e < 4; ++e) { v[j][e] = v[j][e] * rstd * g0[e] + b0[e]; v[j][4 + e] = v[j][4 + e] * rstd * g1[e] + b1[e]; } }
}
__device__ __forceinline__ u32x4 pack8(const float* v) { u32x4 w; w.x = cvt_pk_bf16(v[0], v[1]); w.y = cvt_pk_bf16(v[2], v[3]); w.z = cvt_pk_bf16(v[4], v[5]); w.w = cvt_pk_bf16(v[6], v[7]); return w; }
__device__ __forceinline__ void ln_in_row(const float* src, bf16_t* dstb, const float* __restrict__ gam, const float* __restrict__ bet, int lane) {
    float v[4][8];
#pragma unroll
    for (int j = 0; j < 4; ++j) { const f32x4 a0 = __builtin_nontemporal_load((const f32x4*)src + 2 * (lane + 64 * j)), a1 = __builtin_nontemporal_load((const f32x4*)src + 2 * (lane + 64 * j) + 1);
#pragma unroll
        for (int e = 0; e < 4; ++e) { v[j][e] = a0[e]; v[j][4 + e] = a1[e]; } }
    ln_core(v, gam, bet, lane);
#pragma unroll
    for (int j = 0; j < 4; ++j) ((u32x4*)dstb)[lane + 64 * j] = pack8(v[j]);
}
__device__ __forceinline__ void ln_res16_row(bf16_t* xrow, const bf16_t* yrow, const float* __restrict__ gam, const float* __restrict__ bet, int lane) {
    float v[4][8]; u32x4 xw[4], yw[4];
#pragma unroll
    for (int j = 0; j < 4; ++j) { xw[j] = ((const u32x4*)xrow)[lane + 64 * j]; yw[j] = ((const u32x4*)yrow)[lane + 64 * j]; }
#pragma unroll
    for (int j = 0; j < 4; ++j) { float xv[8], yv[8]; unpack8(xw[j], xv); unpack8(yw[j], yv);
#pragma unroll
        for (int e = 0; e < 8; ++e) v[j][e] = xv[e] * ALPHA + yv[e]; }
    ln_core(v, gam, bet, lane);
#pragma unroll
    for (int j = 0; j < 4; ++j) ((u32x4*)xrow)[lane + 64 * j] = pack8(v[j]);
}
__device__ __forceinline__ void ln_res_final16_row(const bf16_t* xrow, const bf16_t* yrow, float* orow, const float* __restrict__ gam, const float* __restrict__ bet, int lane) {
    float v[4][8]; u32x4 xw[4], yw[4];
#pragma unroll
    for (int j = 0; j < 4; ++j) { xw[j] = ((const u32x4*)xrow)[lane + 64 * j]; yw[j] = ((const u32x4*)yrow)[lane + 64 * j]; }
#pragma unroll
    for (int j = 0; j < 4; ++j) { float xv[8], yv[8]; unpack8(xw[j], xv); unpack8(yw[j], yv);
#pragma unroll
        for (int e = 0; e < 8; ++e) v[j][e] = xv[e] * ALPHA + yv[e]; }
    ln_core(v, gam, bet, lane);
#pragma unroll
    for (int j = 0; j < 4; ++j) { f32x4 o0, o1;
#pragma unroll
        for (int e = 0; e < 4; ++e) { o0[e] = v[j][e]; o1[e] = v[j][4 + e]; }
        ((f32x4*)orow)[2 * (lane + 64 * j)] = o0; ((f32x4*)orow)[2 * (lane + 64 * j) + 1] = o1; }
}

__device__ __forceinline__ void attn_phase(LAS unsigned char* lds, bf16_t* B1, const float* __restrict__ rpb, int chunk, int vcu, int G, int tid, int ooff) {
    const int wave = __builtin_amdgcn_readfirstlane(tid >> 6), lane = tid & 63, l15 = lane & 15, g = lane >> 4;
    const int hsel = wave >> 2, cgp = wave & 3;
    const int kapg = 8 * (g & 1) + 4 * (g >> 1); const int kap15 = 8 * ((l15 >> 2) & 1) + 4 * (l15 >> 3) + (l15 & 3);
    const int rows = chunk ? 128 : 256;
    const int nunits = 1024, per = (nunits + G - 1) / G;
    const int sp = (cgp == 0) ? 0 : (cgp == 1) ? 8 : (cgp == 2) ? 24 : 32;
    const int c = 16 * cgp + l15; const int cs = min(max(c - 8, 0), 48);
    const float scale = 0.08838834764831845f;
    LAS float* btab = (LAS float*)(lds + 131072);
    for (int i = tid; i < 8 * 465; i += 512) btab[i] = rpb[i];
    __syncthreads();
    for (int ui = 0; ui < per; ++ui) {
        const int unit = vcu * per + ui; if (unit >= nunits) break;
        const int hp = unit & 3, rowid = unit >> 2, seq = rowid / rows, r = rowid % rows;
        const int h = 2 * hp + hsel;
        const int rs = min(max(r - 4, 0), rows - 8);
        const size_t seqbase = (size_t)seq * rows * 64;
        const bf16_t* qp = B1 + (seqbase + (size_t)r * 64 + c) * B1_LD + Q_OFF + h * 128 + 8 * g;
        bf16x8 qf[4];
#pragma unroll
        for (int s = 0; s < 4; ++s) qf[s] = *(const bf16x8*)(qp + 32 * s);
        f32x4 sacc[16];
#pragma unroll
        for (int kb = 0; kb < 16; ++kb) { const int ir = kb >> 1, hh = kb & 1;
            const bf16_t* kp = B1 + (seqbase + (size_t)(rs + ir) * 64 + sp + 16 * hh + kap15) * B1_LD + K_OFF + h * 128 + 8 * g;
            bf16x8 kf[4];
#pragma unroll
            for (int s = 0; s < 4; ++s) kf[s] = *(const bf16x8*)(kp + 32 * s);
            f32x4 ac = (f32x4){0.f, 0.f, 0.f, 0.f};
#pragma unroll
            for (int s = 0; s < 4; ++s) ac = __builtin_amdgcn_mfma_f32_16x16x32_bf16(kf[s], qf[s], ac, 0, 0, 0);
            sacc[kb] = ac; }
        const LAS float* tb = btab + h * 465;
        float mx = -1e30f;
#pragma unroll
        for (int kb = 0; kb < 16; ++kb) { const int ir = kb >> 1, hh = kb & 1;
#pragma unroll
            for (int i = 0; i < 4; ++i) { const int kc = sp + 16 * hh + kapg + i; const bool valid = (kc >= cs) && (kc < cs + 16);
                int bidx = (rs + ir - r + 7) * 31 + (kc - c + 15); bidx = valid ? bidx : 0;
                const float bias = tb[bidx]; const float sv = valid ? sacc[kb][i] * scale + bias : -1e30f;
                sacc[kb][i] = sv; mx = fmaxf(mx, sv); } }
        mx = fmaxf(mx, __shfl_xor(mx, 16)); mx = fmaxf(mx, __shfl_xor(mx, 32));
        float sum = 0.f;
#pragma unroll
        for (int kb = 0; kb < 16; ++kb)
#pragma unroll
            for (int i = 0; i < 4; ++i) { const float p = __expf(sacc[kb][i] - mx); sum += p; sacc[kb][i] = p; }
        sum += __shfl_xor(sum, 16); sum += __shfl_xor(sum, 32);
        const float inv = 1.0f / sum;
        bf16x8 pf[8];
#pragma unroll
        for (int ks = 0; ks < 8; ++ks) { u32x4 w; w.x = cvt_pk_bf16(sacc[2 * ks][0], sacc[2 * ks][1]); w.y = cvt_pk_bf16(sacc[2 * ks][2], sacc[2 * ks][3]);
            w.z = cvt_pk_bf16(sacc[2 * ks + 1][0], sacc[2 * ks + 1][1]); w.w = cvt_pk_bf16(sacc[2 * ks + 1][2], sacc[2 * ks + 1][3]); pf[ks] = __builtin_bit_cast(bf16x8, w); }
        f32x4 oacc[8];
#pragma unroll
        for (int nb = 0; nb < 8; ++nb) oacc[nb] = (f32x4){0.f, 0.f, 0.f, 0.f};
        const int q4 = l15 >> 2, p4 = l15 & 3;
#pragma unroll
        for (int pass = 0; pass < 2; ++pass) {
            __syncthreads();
#pragma unroll
            for (int b8 = 0; b8 < 2; ++b8) { u32x4 tmp[8];
#pragma unroll
                for (int it = 0; it < 8; ++it) { const int cidx = (b8 * 8 + it) * 512 + tid; const int tk = cidx >> 5, hs = (cidx >> 4) & 1, ch = cidx & 15;
                    tmp[it] = *(const u32x4*)(B1 + (seqbase + (size_t)(rs + 4 * pass) * 64 + tk) * B1_LD + V_OFF + (2 * hp + hs) * 128 + ch * 8); }
#pragma unroll
                for (int it = 0; it < 8; ++it) { const int cidx = (b8 * 8 + it) * 512 + tid; const int tk = cidx >> 5, hs = (cidx >> 4) & 1, ch = cidx & 15;
                    *(LAS u32x4*)(lds + hs * 65536 + 256 * tk + 16 * (ch ^ swz16(tk))) = tmp[it]; } }
            __syncthreads();
            const LAS unsigned char* vb = lds + hsel * 65536;
#pragma unroll
            for (int ksl = 0; ksl < 4; ++ksl) {
                const int row1 = ksl * 64 + sp + kapg + q4, row2 = row1 + 16;
#pragma unroll
                for (int nb = 0; nb < 8; ++nb) { const int ch = 2 * nb + (p4 >> 1);
                    const s16x4 t1 = vtr(vb + 256 * row1 + 16 * (ch ^ swz16(row1)) + 8 * (p4 & 1));
                    const s16x4 t2 = vtr(vb + 256 * row2 + 16 * (ch ^ swz16(row2)) + 8 * (p4 & 1));
                    oacc[nb] = __builtin_amdgcn_mfma_f32_16x16x32_bf16(cat8(t1, t2), pf[pass * 4 + ksl], oacc[nb], 0, 0, 0); } }
        }
        bf16_t* op = B1 + (seqbase + (size_t)r * 64 + c) * B1_LD + ooff + h * 128 + 4 * g;
#pragma unroll
        for (int nb = 0; nb < 8; ++nb) { u32x2 w; w.x = cvt_pk_bf16(oacc[nb][0] * inv, oacc[nb][1] * inv); w.y = cvt_pk_bf16(oacc[nb][2] * inv, oacc[nb][3] * inv); *(u32x2*)(op + 16 * nb) = w; }
    }
    __syncthreads();
}

__device__ __forceinline__ int f_off(int row, int ch) { return 512 * row + 16 * (ch ^ swz16(row)); }

__device__ __forceinline__ void four1_phase(LAS unsigned char* lds, const bf16_t* B1, bf16_t* Z, int chunk, int vcu, int G, int tid) {
    const int wave = __builtin_amdgcn_readfirstlane(tid >> 6), lane = tid & 63, l15 = lane & 15, g = lane >> 4, q4 = l15 >> 2, p4 = l15 & 3;
    const int N2 = chunk ? 64 : 128, nseq = chunk ? 2 : 1, T = 128 * N2;
    const int nunits = nseq * N2 * 4, per = (nunits + G - 1) / G;
    const int k1 = 16 * wave + l15;
    bf16x8 Fc[4], Fs[4];
#pragma unroll
    for (int s = 0; s < 4; ++s) { unsigned wc_[4], ws_[4];
#pragma unroll
        for (int jj = 0; jj < 4; ++jj) { float c0, s0, c1, s1; const int t1a = 32 * s + 8 * g + 2 * jj, t1b = t1a + 1;
            sincospif((float)((k1 * t1a) & 127) * (1.0f / 64.0f), &s0, &c0); sincospif((float)((k1 * t1b) & 127) * (1.0f / 64.0f), &s1, &c1);
            const float sc = 0.08838834764831845f;
            wc_[jj] = cvt_pk_bf16(c0 * sc, c1 * sc); ws_[jj] = cvt_pk_bf16(s0 * sc, s1 * sc); }
        Fc[s] = __builtin_bit_cast(bf16x8, (u32x4){wc_[0], wc_[1], wc_[2], wc_[3]}); Fs[s] = __builtin_bit_cast(bf16x8, (u32x4){ws_[0], ws_[1], ws_[2], ws_[3]}); }
    const int trow0 = tid >> 5, tch = tid & 31;
    u32x4 treg[8];
    if (vcu * per < nunits) { const int unit = vcu * per; const int gq = unit & 3, rest = unit >> 2, t2 = rest % N2, seq = rest / N2;
        const bf16_t* tb = B1 + ((size_t)seq * T + (size_t)trow0 * N2 + t2) * B1_LD + VR_OFF + gq * 256 + tch * 8;
#pragma unroll
        for (int it = 0; it < 8; ++it) treg[it] = *(const u32x4*)(tb + (size_t)it * 16 * N2 * B1_LD); }
    for (int ui = 0; ui < per; ++ui) {
        const int unit = vcu * per + ui; if (unit >= nunits) break;
        const int gq = unit & 3, rest = unit >> 2, t2 = rest % N2, seq = rest / N2;
        const size_t seqbase = (size_t)seq * T;
        __syncthreads();
#pragma unroll
        for (int it = 0; it < 8; ++it) *(LAS u32x4*)(lds + f_off(16 * it + trow0, tch)) = treg[it];
        if (ui + 1 < per && unit + 1 < nunits) { const int un = unit + 1; const int gqn = un & 3, restn = un >> 2, t2n = restn % N2, seqn = restn / N2;
            const bf16_t* tb = B1 + ((size_t)seqn * T + (size_t)trow0 * N2 + t2n) * B1_LD + VR_OFF + gqn * 256 + tch * 8;
#pragma unroll
            for (int it = 0; it < 8; ++it) treg[it] = *(const u32x4*)(tb + (size_t)it * 16 * N2 * B1_LD); }
        __syncthreads();
        float cph, sph; sincospif((float)(k1 * t2) * (2.0f / (float)T), &sph, &cph);
        bf16_t* zrow = Z + (seqbase + (size_t)k1 * N2 + t2) * Z_LD + gq * 512 + 8 * g;
#pragma unroll 2
        for (int nb = 0; nb < 16; ++nb) {
            f32x4 ac = (f32x4){0.f, 0.f, 0.f, 0.f}, as = (f32x4){0.f, 0.f, 0.f, 0.f};
#pragma unroll
            for (int s = 0; s < 4; ++s) { const int r1 = 32 * s + 8 * g + q4, r2 = r1 + 4, ch = 2 * nb + (p4 >> 1);
                const bf16x8 af = cat8(vtr(lds + f_off(r1, ch) + 8 * (p4 & 1)), vtr(lds + f_off(r2, ch) + 8 * (p4 & 1)));
                ac = __builtin_amdgcn_mfma_f32_16x16x32_bf16(af, Fc[s], ac, 0, 0, 0); as = __builtin_amdgcn_mfma_f32_16x16x32_bf16(af, Fs[s], as, 0, 0, 0); }
            u32x4 w;
            w.x = cvt_pk_bf16(ac[0] * cph - as[0] * sph, -as[0] * cph - ac[0] * sph); w.y = cvt_pk_bf16(ac[1] * cph - as[1] * sph, -as[1] * cph - ac[1] * sph);
            w.z = cvt_pk_bf16(ac[2] * cph - as[2] * sph, -as[2] * cph - ac[2] * sph); w.w = cvt_pk_bf16(ac[3] * cph - as[3] * sph, -as[3] * cph - ac[3] * sph);
            *(u32x4*)(zrow + 32 * nb) = w; }
    }
    __syncthreads();
}

__device__ __forceinline__ void four2_phase(LAS unsigned char* lds, const bf16_t* Z, bf16_t* B1, int chunk, int vcu, int G, int tid) {
    const int wave = __builtin_amdgcn_readfirstlane(tid >> 6), lane = tid & 63, l15 = lane & 15, g = lane >> 4, q4 = l15 >> 2, p4 = l15 & 3;
    const int N2 = chunk ? 64 : 128, nseq = chunk ? 2 : 1, T = 128 * N2;
    const int nunits = nseq * 128 * 8, per = (nunits + G - 1) / G;
    const int nkb = N2 >> 4, kb = wave % nkb, npart = wave / nkb, nbn = 16 / (8 / nkb), nsteps = N2 >> 5;
    const int k2 = 16 * kb + l15;
    const float sc = chunk ? 0.125f : 0.08838834764831845f; const float angs = 2.0f / (float)N2;
    bf16x8 Fc[4], Fs[4];
#pragma unroll
    for (int s = 0; s < 4; ++s) { unsigned wc_[4], ws_[4];
#pragma unroll
        for (int jj = 0; jj < 4; ++jj) { float c0, s0, c1, s1; const int ta = 32 * s + 8 * g + 2 * jj, tb = ta + 1;
            sincospif((float)((k2 * ta) & (N2 - 1)) * angs, &s0, &c0); sincospif((float)((k2 * tb) & (N2 - 1)) * angs, &s1, &c1);
            wc_[jj] = cvt_pk_bf16(c0 * sc, c1 * sc); ws_[jj] = cvt_pk_bf16(s0 * sc, s1 * sc); }
        Fc[s] = __builtin_bit_cast(bf16x8, (u32x4){wc_[0], wc_[1], wc_[2], wc_[3]}); Fs[s] = __builtin_bit_cast(bf16x8, (u32x4){ws_[0], ws_[1], ws_[2], ws_[3]}); }
    const int nchunks = N2 * 32 / 512;
    const int trow0 = tid >> 5, tch = tid & 31;
    u32x4 treg[8];
    if (vcu * per < nunits) { const int unit = vcu * per; const int cb = unit & 7, rest = unit >> 3, k1 = rest & 127, seq = rest >> 7;
        const bf16_t* tb = Z + ((size_t)seq * T + (size_t)k1 * N2 + trow0) * Z_LD + cb * 256 + tch * 8;
#pragma unroll
        for (int it = 0; it < 8; ++it) if (it < nchunks) treg[it] = *(const u32x4*)(tb + (size_t)it * 16 * Z_LD); }
    for (int ui = 0; ui < per; ++ui) {
        const int unit = vcu * per + ui; if (unit >= nunits) break;
        const int cb = unit & 7, rest = unit >> 3, k1 = rest & 127, seq = rest >> 7;
        const size_t seqbase = (size_t)seq * T;
        __syncthreads();
#pragma unroll
        for (int it = 0; it < 8; ++it) if (it < nchunks) *(LAS u32x4*)(lds + f_off(16 * it + trow0, tch)) = treg[it];
        if (ui + 1 < per && unit + 1 < nunits) { const int un = unit + 1; const int cbn = un & 7, restn = un >> 3, k1n = restn & 127, seqn = restn >> 7;
            const bf16_t* tb = Z + ((size_t)seqn * T + (size_t)k1n * N2 + trow0) * Z_LD + cbn * 256 + tch * 8;
#pragma unroll
            for (int it = 0; it < 8; ++it) if (it < nchunks) treg[it] = *(const u32x4*)(tb + (size_t)it * 16 * Z_LD); }
        __syncthreads();
        bf16_t* orow = B1 + (seqbase + (size_t)k1 + 128 * (size_t)k2) * B1_LD + cb * 128 + 2 * g;
        for (int nbi = 0; nbi < nbn; ++nbi) { const int nb = npart * nbn + nbi;
            f32x4 pc = (f32x4){0.f, 0.f, 0.f, 0.f}, ps = (f32x4){0.f, 0.f, 0.f, 0.f};
#pragma unroll
            for (int s = 0; s < 4; ++s) { if (s < nsteps) { const int r1 = 32 * s + 8 * g + q4, r2 = r1 + 4, ch = 2 * nb + (p4 >> 1);
                const bf16x8 af = cat8(vtr(lds + f_off(r1, ch) + 8 * (p4 & 1)), vtr(lds + f_off(r2, ch) + 8 * (p4 & 1)));
                pc = __builtin_amdgcn_mfma_f32_16x16x32_bf16(af, Fc[s], pc, 0, 0, 0); ps = __builtin_amdgcn_mfma_f32_16x16x32_bf16(af, Fs[s], ps, 0, 0, 0); } }
            const unsigned vr = cvt_pk_bf16(pc[0] + ps[1], pc[2] + ps[3]), vi = cvt_pk_bf16(pc[1] - ps[0], pc[3] - ps[2]);
            *(unsigned*)(orow + VR_OFF + 8 * nb) = vr; *(unsigned*)(orow + VI_OFF + 8 * nb) = vi; }
    }
    __syncthreads();
}


#define XB_TMO      128
#define XB_XCNT(j)  (256  + 64 * (j))
#define XB_XSUB(j)  (1280 + 64 * (j))
#define XB_XGEN(j)  (2304 + 64 * (j))
#define XB_TOP      3328
#define XB_TOPGEN   3392
#define XCD_BAR_WORDS 3456
#define XB_SPIN_CAP (1u << 18)
__device__ __forceinline__ unsigned xb_ld(unsigned* p)              { return __hip_atomic_load(p, __ATOMIC_RELAXED, __HIP_MEMORY_SCOPE_AGENT); }
__device__ __forceinline__ unsigned xb_add(unsigned* p, unsigned v) { return __hip_atomic_fetch_add(p, v, __ATOMIC_RELAXED, __HIP_MEMORY_SCOPE_AGENT); }
__device__ __forceinline__ unsigned xb_xcc_id() { return (unsigned)__builtin_amdgcn_s_getreg((3 << 11) | 20) & 0xFu; }
#define XB_SPIN(cond, bar) do { unsigned _sp = 0; while (cond) { __builtin_amdgcn_s_sleep(1); \
    if ((++_sp & 255u) == 0u) { if (xb_ld(&(bar)[XB_TMO])) break; if (_sp > XB_SPIN_CAP) { atomicAdd(&(bar)[XB_TMO], 1u); break; } } } } while (0)
struct XcdBarrier { unsigned* bar; unsigned x; volatile LAS unsigned* st; };
__device__ __forceinline__ XcdBarrier xcd_barrier_post(unsigned* bar, volatile LAS unsigned* st) {
    XcdBarrier b; b.bar = bar; b.x = xb_xcc_id(); b.st = st;
    if (threadIdx.x == 0) (void)xb_add(&bar[XB_XCNT(b.x)], 1u);
    return b;
}
__device__ __forceinline__ void xcd_barrier_complete(unsigned* bar, unsigned x, unsigned& nloc, unsigned& nx) {
    const unsigned G = gridDim.x * gridDim.y * gridDim.z;
    unsigned sum, cnt, mine, sp = 0u;
    for (;;) {
        sum = 0u; cnt = 0u; mine = 0u;
#pragma unroll
        for (unsigned j = 0; j < 16; ++j) { const unsigned c = xb_ld(&bar[XB_XCNT(j)]); sum += c; cnt += (c > 0u) ? 1u : 0u; mine = (j == x) ? c : mine; }
        if (sum == G) break;
        __builtin_amdgcn_s_sleep(1);
        if ((++sp & 255u) == 0u) { if (xb_ld(&bar[XB_TMO])) break; if (sp > XB_SPIN_CAP) { atomicAdd(&bar[XB_TMO], 1u); break; } }
    }
    nloc = mine > 0u ? mine : 1u; nx = cnt > 0u ? cnt : 1u;
}
__device__ __forceinline__ void xcd_barrier(const XcdBarrier& b) {
    asm volatile("s_waitcnt vmcnt(0)" ::: "memory");
    __syncthreads();
    if (threadIdx.x == 0) {
        unsigned* bar = b.bar;
        __builtin_amdgcn_s_waitcnt(0);
        unsigned nloc = b.st[0], nx = b.st[1];
        if (nloc == 0u) { xcd_barrier_complete(bar, b.x, nloc, nx); b.st[0] = nloc; b.st[1] = nx; }
        const unsigned old = xb_add(&bar[XB_XSUB(b.x)], 1u);
        const unsigned gen = old / nloc;
        if (old + 1u == (gen + 1u) * nloc) {
            __builtin_amdgcn_fence(__ATOMIC_RELEASE, "agent");
            asm volatile("s_waitcnt vmcnt(0)" ::: "memory");
            const unsigned og = xb_add(&bar[XB_TOP], 1u);
            const unsigned tg = og / nx;
            if (og + 1u == (tg + 1u) * nx) xb_add(&bar[XB_TOPGEN], 1u);
            else XB_SPIN(xb_ld(&bar[XB_TOPGEN]) == tg, bar);
            __builtin_amdgcn_fence(__ATOMIC_ACQUIRE, "agent");
            xb_add(&bar[XB_XGEN(b.x)], 1u);
            asm volatile("s_waitcnt vmcnt(0)" ::: "memory");
        } else {
            XB_SPIN(xb_ld(&bar[XB_XGEN(b.x)]) == gen, bar);
            __builtin_amdgcn_fence(__ATOMIC_ACQUIRE, "agent");
            asm volatile("s_waitcnt vmcnt(0)" ::: "memory");
        }
    }
    __syncthreads();
}

enum { K_P1 = 0, K_ATT = 1, K_F2 = 2, K_P3 = 3, K_P4 = 4, K_LN1 = 5, K_P5 = 6, K_P6 = 7, K_LN2 = 8 };
constexpr int PH_PER_LAYER = 13, N_PHASES = 1 + DEPTH * PH_PER_LAYER;

__global__ void __launch_bounds__(512, 2) fwd_mega(Args a) {
    extern __shared__ __attribute__((aligned(16))) unsigned char lds_raw[];
    LAS unsigned char* lds = (LAS unsigned char*)lds_raw;
    cg::grid_group grid = cg::this_grid();
    const int G0 = gridDim.x, bx0 = blockIdx.x;
    unsigned char* ws = a.ws;
    bf16_t* Bt1 = (bf16_t*)(ws + WS_BT1); bf16_t* Bt3 = (bf16_t*)(ws + WS_BT3); bf16_t* WfT = (bf16_t*)(ws + WS_WFT); bf16_t* Bt4 = (bf16_t*)(ws + WS_BT4);
    bf16_t* Bt5 = (bf16_t*)(ws + WS_BT5); bf16_t* Bt6 = (bf16_t*)(ws + WS_BT6); bf16_t* Tab = (bf16_t*)(ws + WS_TAB);
    bf16_t* XB = (bf16_t*)(ws + WS_XB); bf16_t* B1 = (bf16_t*)(ws + WS_B1); bf16_t* Gt = (bf16_t*)(ws + WS_G); bf16_t* Z = (bf16_t*)(ws + WS_Z); bf16_t* Hb = (bf16_t*)(ws + WS_H);
    bf16_t* YLA = (bf16_t*)(ws + WS_BT1); bf16_t* YLB = (bf16_t*)(ws + WS_YB);
    float* X = a.out; bf16_t* Y16 = (bf16_t*)a.out; bf16_t* MbAll = (bf16_t*)a.out + (size_t)TALL * DM;
    volatile LAS unsigned* bst = (volatile LAS unsigned*)(lds + 147440);
    if (threadIdx.x < 2) bst[threadIdx.x] = 0u;
    __syncthreads();
    const XcdBarrier xbar = xcd_barrier_post((unsigned*)(ws + WS_CTL), bst);

    for (int ph = a.ph_lo; ph < a.ph_hi; ++ph) {
        int tid = threadIdx.x; asm volatile("" : "+v"(tid));
        int G = G0, bx = bx0; asm volatile("" : "+s"(G), "+s"(bx));
        const int vcu = (G % 8 == 0) ? (bx % 8) * (G / 8) + bx / 8 : bx; const int NGW = G * 8;
        const int lane = tid & 63, wave = __builtin_amdgcn_readfirstlane(tid >> 6), gw = vcu * 8 + wave;
        if (ph == 0) {
            wphase(a, 0, lds, gw, NGW, wave, lane);
            for (int m = gw; m < TALL; m += NGW) { const float* src = (m < CHT) ? a.in[0] + (size_t)m * DM : a.in[1] + (size_t)(m - CHT) * DM;
                ln_in_row(src, XB + (size_t)m * DM, a.in[2], a.in[3], lane); }
        } else {
            const int layer = (ph - 1) / PH_PER_LAYER, r = (ph - 1) % PH_PER_LAYER;
            const int chunk = (r < 8) ? r / 4 : 0, kind = (r < 8) ? r % 4 : r - 4;
            if (kind == K_P1) {
                { pg8::Gemm gm{XB + (size_t)chunk * CHT * DM, Bt1, DM, DM, DM}; pg8::StaticOrder S; S.init(CHT, 8192, G, bx);
                  pg8::EpiP1 E{B1, Gt, a.in[9] + (size_t)layer * 4096};
                  pg8::gemm_phase<pg8::EpiP1>(lds, gm, S, E, tid); }
                if (chunk == 0) { pg8::Gemm gm{WfT, Tab, 256, 256, 256}; pg8::StaticOrder S; S.init(8192, 512, G, bx);
                  pg8::EpiFold E{Bt3};
                  pg8::gemm_phase<pg8::EpiFold>(lds, gm, S, E, tid); }
            } else if (kind == K_ATT) {
                attn_phase(lds, B1, a.in[5] + (size_t)layer * 8 * 465, chunk, vcu, G, tid, Q_OFF);
                four1_phase(lds, B1, Z, chunk, vcu, G, tid);
            } else if (kind == K_F2) {
                four2_phase(lds, Z, B1, chunk, vcu, G, tid);
            } else if (kind == K_P3) {
                pg8::Gemm gm{B1, Bt3, B1_LD, 3072, 3072}; pg8::StaticOrder S; S.init(CHT, DM, G, bx);
                pg8::EpiP3 E{Gt, MbAll + (size_t)chunk * CHT * DM};
                pg8::gemm_phase<pg8::EpiP3>(lds, gm, S, E, tid);
            } else if (kind == K_P4) {
                pg8::Gemm gm{MbAll, Bt4, MB_LD, DM, DM}; pg8::StaticOrder S; S.init(TALL, DM, G, bx);
                pg8::EpiY E{Y16, Y16, 1 << 30};
                pg8::gemm_phase<pg8::EpiY>(lds, gm, S, E, tid);
            } else if (kind == K_LN1) {
                const float* gam = a.in[11] + (size_t)layer * DM; const float* bet = a.in[12] + (size_t)layer * DM;
                for (int m = gw; m < TALL; m += NGW) ln_res16_row(XB + (size_t)m * DM, Y16 + (size_t)m * DM, gam, bet, lane);
            } else if (kind == K_P5) {
                pg8::Gemm gm{XB, Bt5, DM, DM, DM}; pg8::StaticOrder S; S.init(TALL, 2 * DFF, G, bx);
                pg8::EpiSwiglu E{Hb};
                pg8::gemm_phase<pg8::EpiSwiglu>(lds, gm, S, E, tid);
            } else if (kind == K_P6) {
                pg8::Gemm gm{Hb, Bt6, H_LD, DFF, DFF}; pg8::StaticOrder S; S.init(TALL, DM, G, bx);
                const pg8::EpiY E = (layer + 1 < DEPTH) ? pg8::EpiY{Y16, Y16, 1 << 30} : pg8::EpiY{YLA, YLB - (size_t)25600 * DM, 100};
                pg8::gemm_phase<pg8::EpiY>(lds, gm, S, E, tid);
            } else {
                const float* gam = a.in[16] + (size_t)layer * DM; const float* bet = a.in[17] + (size_t)layer * DM;
                if (layer + 1 < DEPTH) { for (int m = gw; m < TALL; m += NGW) ln_res16_row(XB + (size_t)m * DM, Y16 + (size_t)m * DM, gam, bet, lane); }
                else { for (int m = gw; m < TALL; m += NGW) ln_res_final16_row(XB + (size_t)m * DM, (m < 25600 ? YLA : YLB - (size_t)25600 * DM) + (size_t)m * DM, X + (size_t)m * DM, gam, bet, lane); }
                if (layer + 1 < DEPTH) wphase(a, layer + 1, lds, gw, NGW, wave, lane);
            }
        }
        if (ph + 1 < a.ph_hi) {
            if (a.ph_hi > (1 << 20)) grid.sync();
            xcd_barrier(xbar);
        }
    }
}

extern "C" void kernel_launch(void* const* d_in, const int* in_sizes, int n_in, void* d_out, int out_size, void* d_ws, size_t ws_size, hipStream_t stream) {
    static int grid = 0;
    if (grid == 0) {
        if (n_in != 18 || out_size != TALL * DM || ws_size < WS_END) { fprintf(stderr, "kernel_launch: unexpected shapes (n_in %d out %d ws %zu, need ws >= %zu)\n", n_in, out_size, ws_size, (size_t)WS_END); grid = -1; return; }
        int dev = 0, cus = 0, per_cu = 0;
        hipGetDevice(&dev); hipDeviceGetAttribute(&cus, hipDeviceAttributeMultiprocessorCount, dev);
        if (hipFuncSetAttribute((const void*)fwd_mega, hipFuncAttributeMaxDynamicSharedMemorySize, LDS_BYTES) != hipSuccess) { fprintf(stderr, "kernel_launch: hipFuncSetAttribute failed\n"); grid = -1; return; }
        if (hipOccupancyMaxActiveBlocksPerMultiprocessor(&per_cu, (const void*)fwd_mega, 512, LDS_BYTES) != hipSuccess || per_cu < 1) { fprintf(stderr, "kernel_launch: occupancy query says %d\n", per_cu); per_cu = 1; }
        (void)hipGetLastError();
        grid = cus * 1;
    }
    if (grid < 0) return;
    if (hipMemsetAsync((char*)d_ws + WS_CTL, 0, 65536, stream) != hipSuccess) { fprintf(stderr, "kernel_launch: memset failed\n"); return; }
    Args a{};
    for (int i = 0; i < 18; ++i) a.in[i] = (const float*)d_in[i];
    a.out = (float*)d_out; a.ws = (unsigned char*)d_ws;
#if MK_PER_PHASE
    for (int ph = 0; ph < N_PHASES; ++ph) { a.ph_lo = ph; a.ph_hi = ph + 1; hipLaunchKernelGGL(fwd_mega, dim3(grid), dim3(512), LDS_BYTES, stream, a); }
#else
    a.ph_lo = 0; a.ph_hi = N_PHASES;
    void* args[] = {&a};
    hipError_t e = hipLaunchCooperativeKernel((const void*)fwd_mega, dim3(grid), dim3(512), args, LDS_BYTES, stream);
    if (e != hipSuccess) fprintf(stderr, "cooperative launch failed: %s (grid %d)\n", hipGetErrorString(e), grid);
#endif
}
```

```cpp
#include <hip/hip_runtime.h>
#include <hip/hip_cooperative_groups.h>
#include <cstdio>
#include <cstdint>
namespace cg = cooperative_groups;

#define LAS __attribute__((address_space(3)))
typedef unsigned short bf16_t;
typedef short bf16x8 __attribute__((ext_vector_type(8)));
typedef short s16x4 __attribute__((ext_vector_type(4)));
typedef float f32x4 __attribute__((ext_vector_type(4)));
typedef float f32x2 __attribute__((ext_vector_type(2)));
typedef unsigned u32x4 __attribute__((ext_vector_type(4)));
typedef unsigned u32x2 __attribute__((ext_vector_type(2)));

#ifndef MK_PER_PHASE
#define MK_PER_PHASE 0
#endif

constexpr int DM = 2048, TALL = 32768, CHT = 16384, DEPTH = 2, DFF = 5632;
constexpr int B1_LD = 5120, Q_OFF = 0, VR_OFF = 1024, VI_OFF = 2048, K_OFF = 3072, V_OFF = 4096;
constexpr int G_LD = 4096, Z_LD = 2048, MB_LD = 2048, H_LD = 5632;
constexpr float LN_EPS = 1e-5f;
constexpr float ALPHA = 1.41421356237309515f;

constexpr size_t MiB = 1u << 20;
constexpr size_t WS_BT1 = 0, WS_BT3 = 32 * MiB, WS_WFT = 44 * MiB, WS_BT4 = 48 * MiB, WS_BT5 = 56 * MiB, WS_BT6 = 100 * MiB, WS_TAB = 122 * MiB;
constexpr size_t WS_XB = 124 * MiB, WS_R = 252 * MiB, WS_B1 = WS_R, WS_G = WS_R + 160 * MiB, WS_Z = WS_R + 288 * MiB, WS_H = WS_R, WS_CTL = WS_R + 352 * MiB, WS_YB = WS_CTL + 1 * MiB, WS_END = WS_YB + 28 * MiB;
constexpr int LDS_BYTES = 147456;

typedef __bf16 bf16x2_t __attribute__((ext_vector_type(2)));
__device__ __forceinline__ unsigned cvt_pk_bf16(float lo, float hi) { const f32x2 v = {lo, hi}; const bf16x2_t b = __builtin_convertvector(v, bf16x2_t); return __builtin_bit_cast(unsigned, b); }
__device__ __forceinline__ float bf_lo(unsigned w) { return __uint_as_float(w << 16); }
__device__ __forceinline__ float bf_hi(unsigned w) { return __uint_as_float(w & 0xffff0000u); }
__device__ __forceinline__ float rcpf_(float x) { return __builtin_amdgcn_rcpf(x); }
__device__ __forceinline__ float sigmoidf_(float x) { return rcpf_(1.0f + __builtin_amdgcn_exp2f(x * -1.4426950408889634f)); }

namespace pg8 {
constexpr int BM = 256, BK = 64, HALF = 128, HTB = HALF * BK * 2, STAGE_BYTES = 8 * HTB, NXCD = 8, WGM = 8;
__host__ __device__ __forceinline__ int lds_byte(int r, int c) { const int st = (r >> 4) * 2 + (c >> 5), rr = r & 15, cc = c & 31, ob = rr * 64 + cc * 2; return st * 1024 + (ob ^ (((ob >> 9) & 1) << 5)); }
__host__ __device__ __forceinline__ void stage_rc(int b, int& R, int& C) { const int st = b / 1024, sb = b % 1024, swz = sb ^ (((sb >> 9) & 1) << 5); R = (st >> 1) * 16 + swz / 64; C = (st & 1) * 32 + (swz % 64) / 2; }
__host__ __device__ __forceinline__ int perm32(int rho) { const int n = rho >> 4, i = rho & 15; return 8 * (i >> 2) + 4 * n + (i & 3); }

struct Unit { int pm, pn; };
struct Gemm { const bf16_t* A; const bf16_t* Bt; int lda, ldb, K; };

struct StaticOrder {
    int nM, nN, nwg, G, c;
    __host__ __device__ void init(int M, int N, int G_, int c_) { nM = M / BM; nN = N / BM; nwg = nM * nN; G = G_; c = c_; }
    __host__ __device__ bool next(int i, Unit& u) const {
        const long L = (long)i * G + c; if (L >= nwg) return false;
        int wgid = (int)L; { const int q = nwg / NXCD, r = nwg % NXCD, xcd = wgid % NXCD, off = wgid / NXCD; wgid = (xcd < r ? xcd * (q + 1) : r * (q + 1) + (xcd - r) * q) + off; }
        const int nig = WGM * nN, gid = wgid / nig, fm = gid * WGM, gsz = (nM - fm) < WGM ? (nM - fm) : WGM;
        u.pm = fm + ((wgid % nig) % gsz); u.pn = (wgid % nig) / gsz; return true;
    }
};

typedef f32x4 Acc[2][2][4][2];

struct EpiP1 {
    static constexpr bool PERM = true; static constexpr int MID_T = -1;
    bf16_t* B1; bf16_t* G; const float* bgate;
    __device__ __forceinline__ void mid(Acc&, const Unit&, int, int, int, int) const {}
    __device__ __forceinline__ void operator()(const Acc& acc, const Unit& u, int wr, int wc, int fr, int fq) const {
        const int row0 = u.pm * BM + wr * 64 + fr; const int ct = u.pn;
        if (ct < 16) {
            const int seg = ct >> 2;
            const int coff = (seg == 0 ? Q_OFF : seg == 1 ? K_OFF : seg == 2 ? V_OFF : VR_OFF) + (ct & 3) * 256 + wc * 32 + 8 * fq;
#pragma unroll
            for (int ai = 0; ai < 2; ++ai)
#pragma unroll
                for (int m = 0; m < 4; ++m) { bf16_t* rowp = B1 + (size_t)(row0 + ai * HALF + m * 16) * B1_LD + coff;
#pragma unroll
                    for (int bj = 0; bj < 2; ++bj) { const f32x4 v0 = acc[ai][bj][m][0], v1 = acc[ai][bj][m][1];
                        u32x4 w; w.x = cvt_pk_bf16(v0[0], v0[1]); w.y = cvt_pk_bf16(v0[2], v0[3]); w.z = cvt_pk_bf16(v1[0], v1[1]); w.w = cvt_pk_bf16(v1[2], v1[3]);
                        *(u32x4*)(rowp + bj * HALF) = w; } }
        } else {
            const int gcol0 = (ct - 16) * HALF + wc * 32 + 8 * fq;
            f32x4 ba[2], bf[2];
#pragma unroll
            for (int n = 0; n < 2; ++n) { ba[n] = *(const f32x4*)(bgate + gcol0 + 4 * n); bf[n] = *(const f32x4*)(bgate + DM + gcol0 + 4 * n); }
#pragma unroll
            for (int ai = 0; ai < 2; ++ai)
#pragma unroll
                for (int m = 0; m < 4; ++m) { bf16_t* rowp = G + (size_t)(row0 + ai * HALF + m * 16) * G_LD + gcol0;
                    f32x4 rr[2], gg[2];
#pragma unroll
                    for (int n = 0; n < 2; ++n) { const f32x4 va = acc[ai][0][m][n] + ba[n], vf = acc[ai][1][m][n] + bf[n];
#pragma unroll
                        for (int j = 0; j < 4; ++j) { const float ea = __builtin_amdgcn_exp2f(va[j] * -1.4426950408889634f), ef = __builtin_amdgcn_exp2f(vf[j] * -1.4426950408889634f);
                            gg[n][j] = rcpf_(1.0f + ef); rr[n][j] = (1.0f + ef) * rcpf_(1.0f + ea); } }
                    u32x4 w; w.x = cvt_pk_bf16(rr[0][0], rr[0][1]); w.y = cvt_pk_bf16(rr[0][2], rr[0][3]); w.z = cvt_pk_bf16(rr[1][0], rr[1][1]); w.w = cvt_pk_bf16(rr[1][2], rr[1][3]);
                    *(u32x4*)rowp = w;
                    u32x4 v; v.x = cvt_pk_bf16(gg[0][0], gg[0][1]); v.y = cvt_pk_bf16(gg[0][2], gg[0][3]); v.z = cvt_pk_bf16(gg[1][0], gg[1][1]); v.w = cvt_pk_bf16(gg[1][2], gg[1][3]);
                    *(u32x4*)(rowp + DM) = v; }
        }
    }
};

struct EpiP3 {
    static constexpr bool PERM = true; static constexpr int MID_T = 16;
    const bf16_t* __restrict__ G; bf16_t* __restrict__ Mb;
    __device__ __forceinline__ void mid(Acc& acc, const Unit& u, int wr, int wc, int fr, int fq) const {
        asm volatile("" : "+v"(fr), "+v"(fq));
        const int row0 = u.pm * BM + wr * 64 + fr, col0 = u.pn * BM + wc * 32 + 8 * fq;
#pragma unroll
        for (int ai = 0; ai < 2; ++ai) {
            u32x4 rr[4][2];
#pragma unroll
            for (int m = 0; m < 4; ++m)
#pragma unroll
                for (int bj = 0; bj < 2; ++bj) rr[m][bj] = __builtin_nontemporal_load((const u32x4*)(G + (size_t)(row0 + ai * HALF + m * 16) * G_LD + col0 + bj * HALF));
#pragma unroll
            for (int m = 0; m < 4; ++m)
#pragma unroll
                for (int bj = 0; bj < 2; ++bj) { const u32x4 a = rr[m][bj]; f32x4 r0, r1;
                    r0[0] = bf_lo(a.x); r0[1] = bf_hi(a.x); r0[2] = bf_lo(a.y); r0[3] = bf_hi(a.y); r1[0] = bf_lo(a.z); r1[1] = bf_hi(a.z); r1[2] = bf_lo(a.w); r1[3] = bf_hi(a.w);
                    acc[ai][bj][m][0] *= r0; acc[ai][bj][m][1] *= r1; }
            asm volatile("" ::: "memory"); }
    }
    __device__ __forceinline__ void operator()(const Acc& acc, const Unit& u, int wr, int wc, int fr, int fq) const {
        const int row0 = u.pm * BM + wr * 64 + fr, col0 = u.pn * BM + wc * 32 + 8 * fq;
#pragma unroll
        for (int ai = 0; ai < 2; ++ai) {
            u32x4 gf[4][2];
#pragma unroll
            for (int m = 0; m < 4; ++m)
#pragma unroll
                for (int bj = 0; bj < 2; ++bj) gf[m][bj] = __builtin_nontemporal_load((const u32x4*)(G + (size_t)(row0 + ai * HALF + m * 16) * G_LD + DM + col0 + bj * HALF));
#pragma unroll
            for (int m = 0; m < 4; ++m)
#pragma unroll
                for (int bj = 0; bj < 2; ++bj) { const u32x4 f = gf[m][bj]; const f32x4 v0 = acc[ai][bj][m][0], v1 = acc[ai][bj][m][1];
                    u32x4 w; w.x = cvt_pk_bf16(v0[0] * bf_lo(f.x), v0[1] * bf_hi(f.x)); w.y = cvt_pk_bf16(v0[2] * bf_lo(f.y), v0[3] * bf_hi(f.y));
                    w.z = cvt_pk_bf16(v1[0] * bf_lo(f.z), v1[1] * bf_hi(f.z)); w.w = cvt_pk_bf16(v1[2] * bf_lo(f.w), v1[3] * bf_hi(f.w));
                    *(u32x4*)(Mb + (size_t)(row0 + ai * HALF + m * 16) * MB_LD + col0 + bj * HALF) = w; }
            asm volatile("" ::: "memory"); }
    }
};

struct EpiY {
    static constexpr bool PERM = true; static constexpr int MID_T = -1;
    bf16_t* Y; bf16_t* Y2; int split;
    __device__ __forceinline__ void mid(Acc&, const Unit&, int, int, int, int) const {}
    __device__ __forceinline__ void operator()(const Acc& acc, const Unit& u, int wr, int wc, int fr, int fq) const {
        const int row0 = u.pm * BM + wr * 64 + fr, col0 = u.pn * BM + wc * 32 + 8 * fq;
        bf16_t* Yb = (u.pm < split) ? Y : Y2;
#pragma unroll
        for (int ai = 0; ai < 2; ++ai)
#pragma unroll
            for (int m = 0; m < 4; ++m) { bf16_t* rowp = Yb + (size_t)(row0 + ai * HALF + m * 16) * DM + col0;
#pragma unroll
                for (int bj = 0; bj < 2; ++bj) { const f32x4 v0 = acc[ai][bj][m][0], v1 = acc[ai][bj][m][1];
                    u32x4 w; w.x = cvt_pk_bf16(v0[0], v0[1]); w.y = cvt_pk_bf16(v0[2], v0[3]); w.z = cvt_pk_bf16(v1[0], v1[1]); w.w = cvt_pk_bf16(v1[2], v1[3]);
                    *(u32x4*)(rowp + bj * HALF) = w; } }
    }
};

struct EpiSwiglu {
    static constexpr bool PERM = true; static constexpr int MID_T = -1;
    bf16_t* H;
    __device__ __forceinline__ void mid(Acc&, const Unit&, int, int, int, int) const {}
    __device__ __forceinline__ void operator()(const Acc& acc, const Unit& u, int wr, int wc, int fr, int fq) const {
        const int row0 = u.pm * BM + wr * 64 + fr, col0 = u.pn * HALF + wc * 32 + 8 * fq;
#pragma unroll
        for (int ai = 0; ai < 2; ++ai)
#pragma unroll
            for (int m = 0; m < 4; ++m) { bf16_t* rowp = H + (size_t)(row0 + ai * HALF + m * 16) * H_LD + col0;
                f32x4 o0, o1;
#pragma unroll
                for (int j = 0; j < 4; ++j) { const float g0 = acc[ai][0][m][0][j], g1 = acc[ai][0][m][1][j];
                    o0[j] = g0 * sigmoidf_(g0) * acc[ai][1][m][0][j]; o1[j] = g1 * sigmoidf_(g1) * acc[ai][1][m][1][j]; }
                u32x4 w; w.x = cvt_pk_bf16(o0[0], o0[1]); w.y = cvt_pk_bf16(o0[2], o0[3]); w.z = cvt_pk_bf16(o1[0], o1[1]); w.w = cvt_pk_bf16(o1[2], o1[3]);
                *(u32x4*)rowp = w; }
    }
};

struct EpiFold {
    static constexpr bool PERM = true; static constexpr int MID_T = -1;
    bf16_t* Bt3;
    __device__ __forceinline__ void mid(Acc&, const Unit&, int, int, int, int) const {}
    __device__ __forceinline__ void operator()(const Acc& acc, const Unit& u, int wr, int wc, int fr, int fq) const {
        const int g = u.pm >> 3, d0 = (u.pm & 7) * 256 + wr * 64 + fr, col0 = 1024 + u.pn * 1024 + g * 256 + wc * 32 + 8 * fq;
#pragma unroll
        for (int ai = 0; ai < 2; ++ai)
#pragma unroll
            for (int m = 0; m < 4; ++m) { bf16_t* rowp = Bt3 + (size_t)(d0 + ai * HALF + m * 16) * 3072 + col0;
#pragma unroll
                for (int bj = 0; bj < 2; ++bj) { const f32x4 v0 = acc[ai][bj][m][0], v1 = acc[ai][bj][m][1];
                    u32x4 w; w.x = cvt_pk_bf16(v0[0], v0[1]); w.y = cvt_pk_bf16(v0[2], v0[3]); w.z = cvt_pk_bf16(v1[0], v1[1]); w.w = cvt_pk_bf16(v1[2], v1[3]);
                    *(u32x4*)(rowp + bj * HALF) = w; } }
    }
};

template <class Epi, bool ALIGN_EPI = true>
__device__ __forceinline__ void gemm_phase(LAS unsigned char* lds, const Gemm g, const StaticOrder& S, const Epi& E, const int tid) {
    const int wid = __builtin_amdgcn_readfirstlane(tid >> 6), lane = tid & 63, wr = wid >> 2, wc = wid & 3, fr = lane & 15, fq = lane >> 4;
    const int K = g.K; int nt = K / BK; asm volatile("" : "+s"(nt));
    unsigned voffA[2], voffB[2];
#pragma unroll
    for (int i = 0; i < 2; ++i) { int R, C; stage_rc(tid * 16 + i * 8192, R, C); const int Rb = Epi::PERM ? ((R & ~31) + perm32(R & 31)) : R;
        voffA[i] = (unsigned)(R * g.lda + C) * 2u; voffB[i] = (unsigned)(Rb * g.ldb + C) * 2u; }
    const size_t kstep = (size_t)(BK * 2);
    const size_t hA = (size_t)HALF * g.lda * 2, hB = (size_t)HALF * g.ldb * 2;
    const size_t tA = 2 * hA, tB = 2 * hB;
    const unsigned ldsw = (unsigned)wid * 1024u;
    const int aoff = lds_byte(wr * 64 + fr, fq * 8), boff = lds_byte(wc * 32 + fr, fq * 8);
#define PG8_SA(b, h) (((b) * 2 + (h)) * HTB)
#define PG8_SB(b, h) ((4 + (b) * 2 + (h)) * HTB)
#define PG8_STAGE(bufoff, gbase, voff) do { _Pragma("unroll") for (int _i = 0; _i < 2; ++_i) \
        __builtin_amdgcn_global_load_lds((const unsigned*)((const char*)(gbase) + (voff)[_i]), (LAS unsigned*)(lds + (bufoff) + ldsw + _i * 8192), 16, 0, 0); } while (0)
#define PG8_LDA(dst, b, h) do { _Pragma("unroll") for (int m = 0; m < 4; ++m) _Pragma("unroll") for (int k = 0; k < 2; ++k) dst[m][k] = *(const LAS bf16x8*)(lds + PG8_SA(b, h) + aoff + m * 2048 + k * 1024); } while (0)
#define PG8_LDB(dst, b, h) do { _Pragma("unroll") for (int n = 0; n < 2; ++n) _Pragma("unroll") for (int k = 0; k < 2; ++k) dst[n][k] = *(const LAS bf16x8*)(lds + PG8_SB(b, h) + boff + n * 2048 + k * 1024); } while (0)
#define PG8_MMA(ai, bj, At, Bt) do { __builtin_amdgcn_s_setprio(1); _Pragma("unroll") for (int m = 0; m < 4; ++m) _Pragma("unroll") for (int n = 0; n < 2; ++n) _Pragma("unroll") for (int k = 0; k < 2; ++k) \
        acc[ai][bj][m][n] = __builtin_amdgcn_mfma_f32_16x16x32_bf16(Bt[n][k], At[m][k], acc[ai][bj][m][n], 0, 0, 0); __builtin_amdgcn_s_setprio(0); } while (0)
#define PG8_WAIT_V(n) asm volatile("s_waitcnt vmcnt(" #n ")" ::: "memory")
#define PG8_WAIT_L(n) asm volatile("s_waitcnt lgkmcnt(" #n ")" ::: "memory")
#define PG8_BAR __builtin_amdgcn_s_barrier()
#define PG8_SCHED __builtin_amdgcn_sched_barrier(0)
    Unit cur, nxt; int ui = 0;
    if (!S.next(0, cur)) return;
    Acc acc;
#pragma unroll
    for (int a = 0; a < 2; ++a)
#pragma unroll
        for (int b = 0; b < 2; ++b)
#pragma unroll
            for (int m = 0; m < 4; ++m)
#pragma unroll
                for (int n = 0; n < 2; ++n) acc[a][b][m][n] = (f32x4){0.f, 0.f, 0.f, 0.f};
    bf16x8 At[4][2], B0[2][2], B1[2][2];
    const char* cA = (const char*)g.A + (size_t)cur.pm * tA; const char* cB = (const char*)g.Bt + (size_t)cur.pn * tB;
    PG8_STAGE(PG8_SB(0, 0), cB, voffB); PG8_STAGE(PG8_SB(0, 1), cB + hB, voffB); PG8_STAGE(PG8_SA(0, 0), cA, voffA); PG8_STAGE(PG8_SA(0, 1), cA + hA, voffA);
    if (wr == 1) PG8_BAR;
    PG8_WAIT_V(2); PG8_BAR;
    PG8_STAGE(PG8_SB(1, 0), cB + kstep, voffB); PG8_STAGE(PG8_SA(1, 0), cA + kstep, voffA); PG8_STAGE(PG8_SB(1, 1), cB + hB + kstep, voffB);
    PG8_WAIT_V(6); PG8_BAR;
    for (;;) {
        const bool has_next = S.next(ui + 1, nxt);
        const char* nA = has_next ? (const char*)g.A + (size_t)nxt.pm * tA : cA; const char* nB = has_next ? (const char*)g.Bt + (size_t)nxt.pn * tB : cB;
        for (int t = 0; t < nt; t += 2) {
            const bool last = (t == nt - 2);
            const char* a1 = cA + (size_t)(t + 1) * kstep;
            const char* a2 = last ? nA : cA + (size_t)(t + 2) * kstep; const char* b2 = last ? nB : cB + (size_t)(t + 2) * kstep;
            const char* a3 = a2 + kstep; const char* b3 = b2 + kstep;
            if constexpr (Epi::MID_T >= 0) { if (t == Epi::MID_T) { E.mid(acc, cur, wr, wc, fr, fq); PG8_SCHED; } }
            PG8_LDB(B0, 0, 0); PG8_LDB(B1, 0, 1); PG8_SCHED; PG8_LDA(At, 0, 0); PG8_STAGE(PG8_SA(1, 1), a1 + hA, voffA);
            PG8_WAIT_V(8); PG8_WAIT_L(0); PG8_BAR; PG8_MMA(0, 0, At, B0); PG8_MMA(0, 1, At, B1); PG8_BAR; PG8_SCHED;
            PG8_LDA(At, 0, 1); PG8_STAGE(PG8_SB(0, 0), b2, voffB); PG8_STAGE(PG8_SB(0, 1), b2 + hB, voffB); PG8_STAGE(PG8_SA(0, 0), a2, voffA);
            PG8_WAIT_V(8); PG8_WAIT_L(0); PG8_BAR; PG8_MMA(1, 0, At, B0); PG8_MMA(1, 1, At, B1); PG8_BAR; PG8_SCHED;
            PG8_LDB(B0, 1, 0); PG8_LDB(B1, 1, 1); PG8_SCHED; PG8_LDA(At, 1, 0); PG8_STAGE(PG8_SA(0, 1), a2 + hA, voffA);
            PG8_WAIT_V(8); PG8_WAIT_L(0); PG8_BAR; PG8_MMA(0, 0, At, B0); PG8_MMA(0, 1, At, B1); PG8_BAR; PG8_SCHED;
            PG8_LDA(At, 1, 1); PG8_STAGE(PG8_SB(1, 0), b3, voffB); PG8_STAGE(PG8_SB(1, 1), b3 + hB, voffB); PG8_STAGE(PG8_SA(1, 0), a3, voffA);
            PG8_WAIT_V(8); PG8_WAIT_L(0); PG8_BAR; PG8_MMA(1, 0, At, B0); PG8_MMA(1, 1, At, B1); PG8_BAR; PG8_SCHED;
        }
        if constexpr (ALIGN_EPI) { if (wr == 0) PG8_BAR; }
        E(acc, cur, wr, wc, fr, fq);
        if (!has_next) break;
#pragma unroll
        for (int a = 0; a < 2; ++a)
#pragma unroll
            for (int b = 0; b < 2; ++b)
#pragma unroll
                for (int m = 0; m < 4; ++m)
#pragma unroll
                    for (int n = 0; n < 2; ++n) acc[a][b][m][n] = (f32x4){0.f, 0.f, 0.f, 0.f};
        cur = nxt; cA = nA; cB = nB; ++ui;
        if constexpr (ALIGN_EPI) { if (wr == 1) PG8_BAR; }
    }
    PG8_WAIT_V(0);
    if constexpr (!ALIGN_EPI) { if (wr == 0) PG8_BAR; }
    PG8_BAR;
#undef PG8_SA
#undef PG8_SB
#undef PG8_STAGE
#undef PG8_LDA
#undef PG8_LDB
#undef PG8_MMA
#undef PG8_WAIT_V
#undef PG8_WAIT_L
#undef PG8_BAR
#undef PG8_SCHED
}
}

#define LDS_WAIT() asm volatile("s_waitcnt lgkmcnt(0)" ::: "memory")
__device__ __forceinline__ float wave_sum(float v) {
#pragma unroll
    for (int o = 1; o < 64; o <<= 1) v += __shfl_xor(v, o);
    return v;
}
__device__ __forceinline__ s16x4 vtr(const LAS unsigned char* p) { return __builtin_bit_cast(s16x4, __builtin_amdgcn_ds_read_tr16_b64_v4i16((LAS s16x4*)p)); }
__device__ __forceinline__ bf16x8 cat8(s16x4 a, s16x4 b) { bf16x8 r; r[0] = a[0]; r[1] = a[1]; r[2] = a[2]; r[3] = a[3]; r[4] = b[0]; r[5] = b[1]; r[6] = b[2]; r[7] = b[3]; return r; }
__device__ __forceinline__ int swz16(int row) { return ((row & 3) << 2) | ((row >> 2) & 3); }

struct Args {
    const float* in[18]; float* out; unsigned char* ws; int ph_lo, ph_hi;
};

__device__ __forceinline__ void transpose_item(const float* __restrict__ W, int ldw, int k0, int n0, bf16_t* WT, int ldo, int drow0, int dcol0, LAS float* scr, int lane) {
    float t32[32];
#pragma unroll
    for (int i = 0; i < 32; ++i) { const int kk = 2 * i + (lane >> 5); t32[i] = __builtin_nontemporal_load(&W[(size_t)(k0 + kk) * ldw + n0 + (lane & 31)]); }
#pragma unroll
    for (int i = 0; i < 32; ++i) { const int kk = 2 * i + (lane >> 5); scr[kk * 33 + (lane & 31)] = t32[i]; }
    LDS_WAIT(); asm volatile("" ::: "memory");
    const int c = lane & 7;
#pragma unroll
    for (int j = 0; j < 4; ++j) { const int n = (lane >> 3) + 8 * j; const LAS float* s = scr + (8 * c) * 33 + n;
        u32x4 o; o.x = cvt_pk_bf16(s[0 * 33], s[1 * 33]); o.y = cvt_pk_bf16(s[2 * 33], s[3 * 33]); o.z = cvt_pk_bf16(s[4 * 33], s[5 * 33]); o.w = cvt_pk_bf16(s[6 * 33], s[7 * 33]);
        *(u32x4*)(WT + (size_t)(drow0 + n) * ldo + dcol0 + 8 * c) = o; }
    LDS_WAIT(); asm volatile("" ::: "memory");
}

__device__ __forceinline__ void wphase(const Args& a, int layer, LAS unsigned char* lds, int gw, int NGW, int wave, int lane) {
    unsigned char* ws = a.ws;
    bf16_t* Bt1 = (bf16_t*)(ws + WS_BT1); bf16_t* Bt3 = (bf16_t*)(ws + WS_BT3); bf16_t* WfT = (bf16_t*)(ws + WS_WFT); bf16_t* Bt4 = (bf16_t*)(ws + WS_BT4);
    bf16_t* Bt5 = (bf16_t*)(ws + WS_BT5); bf16_t* Bt6 = (bf16_t*)(ws + WS_BT6); bf16_t* Tab = (bf16_t*)(ws + WS_TAB);
    const float* w_in = a.in[4] + (size_t)layer * DM * 4096; const float* w_att = a.in[6] + (size_t)layer * 1024 * DM; const float* w_four = a.in[7] + (size_t)layer * 1024 * DM;
    const float* w_gate = a.in[8] + (size_t)layer * DM * 4096; const float* w_out = a.in[10] + (size_t)layer * DM * DM;
    const float* w_fg = a.in[13] + (size_t)layer * DM * DFF; const float* w_fu = a.in[14] + (size_t)layer * DM * DFF; const float* w_fd = a.in[15] + (size_t)layer * DFF * DM;
    LAS float* scr = (LAS float*)(lds + wave * 16384);
    constexpr int I_IN = 32 * 128, I_ATT = 16 * 64, I_OUT = 32 * 64, I_FF = 32 * 176, I_FD = 88 * 64;
    constexpr int NITEMS = 2 * I_IN + 2 * I_ATT + I_OUT + 2 * I_FF + I_FD;
    for (int it = gw; it < NITEMS; it += NGW) {
        int r = it;
        if (r < I_IN) { const int kb = r / 128, nb = r % 128; transpose_item(w_in, 4096, 64 * kb, 32 * nb, Bt1, DM, 32 * nb, 64 * kb, scr, lane); continue; } r -= I_IN;
        if (r < I_IN) { const int kb = r / 128, nb = r % 128; const int n0 = 32 * nb, jj = n0 & 2047; transpose_item(w_gate, 4096, 64 * kb, n0, Bt1, DM, 4096 + 256 * (jj >> 7) + 128 * (n0 >> 11) + (jj & 127), 64 * kb, scr, lane); continue; } r -= I_IN;
        if (r < I_ATT) { const int kb = r / 64, nb = r % 64; transpose_item(w_att, DM, 64 * kb, 32 * nb, Bt3, 3072, 32 * nb, 64 * kb, scr, lane); continue; } r -= I_ATT;
        if (r < I_ATT) { const int kb = r / 64, nb = r % 64; const int k0 = 64 * kb; transpose_item(w_four, DM, k0, 32 * nb, WfT, 256, (k0 >> 8) * 2048 + 32 * nb, k0 & 255, scr, lane); continue; } r -= I_ATT;
        if (r < I_OUT) { const int kb = r / 64, nb = r % 64; transpose_item(w_out, DM, 64 * kb, 32 * nb, Bt4, DM, 32 * nb, 64 * kb, scr, lane); continue; } r -= I_OUT;
        if (r < I_FF) { const int kb = r / 176, nb = r % 176; const int n0 = 32 * nb; transpose_item(w_fg, DFF, 64 * kb, n0, Bt5, DM, 256 * (n0 >> 7) + (n0 & 127), 64 * kb, scr, lane); continue; } r -= I_FF;
        if (r < I_FF) { const int kb = r / 176, nb = r % 176; const int n0 = 32 * nb; transpose_item(w_fu, DFF, 64 * kb, n0, Bt5, DM, 256 * (n0 >> 7) + 128 + (n0 & 127), 64 * kb, scr, lane); continue; } r -= I_FF;
        { const int kb = r / 64, nb = r % 64; transpose_item(w_fd, DM, 64 * kb, 32 * nb, Bt6, DFF, 32 * nb, 64 * kb, scr, lane); }
    }
    for (int e = gw * 64 + lane; e < 512 * 256; e += NGW * 64) { const int kc = e & 255, c = (e >> 8) & 255, cs = e >> 16;
        float sv, cv; sincospif((float)((c * kc) & 255) * (1.0f / 128.0f), &sv, &cv); const float v = (cs ? sv : cv) * 0.0625f;
        Tab[e] = (bf16_t)(cvt_pk_bf16(v, 0.f) & 0xffffu); }
}

__device__ __forceinline__ void unpack8(const u32x4 w, float* v) { v[0] = bf_lo(w.x); v[1] = bf_hi(w.x); v[2] = bf_lo(w.y); v[3] = bf_hi(w.y); v[4] = bf_lo(w.z); v[5] = bf_hi(w.z); v[6] = bf_lo(w.w); v[7] = bf_hi(w.w); }
__device__ __forceinline__ void ln_core(float (&v)[4][8], const float* __restrict__ gam, const float* __restrict__ bet, int lane) {
    float s = 0.f;
#pragma unroll
    for (int j = 0; j < 4; ++j)
#pragma unroll
        for (int e = 0; e < 8; ++e) s += v[j][e];
    const float mean = wave_sum(s) * (1.f / DM); float s2 = 0.f;
#pragma unroll
    for (int j = 0; j < 4; ++j)
#pragma unroll
        for (int e = 0; e < 8; ++e) { v[j][e] -= mean; s2 += v[j][e] * v[j][e]; }
    const float rstd = 1.f / sqrtf(wave_sum(s2) * (1.f / DM) + LN_EPS);
#pragma unroll
    for (int j = 0; j < 4; ++j) { const f32x4 g0 = ((const f32x4*)gam)[2 * (lane + 64 * j)], g1 = ((const f32x4*)gam)[2 * (lane + 64 * j) + 1];
        const f32x4 b0 = ((const f32x4*)bet)[2 * (lane + 64 * j)], b1 = ((const f32x4*)bet)[2 * (lane + 64 * j) + 1];
#pragma unroll
        for (int e = 0; e < 4; ++e) { v[j][e] = v[j][e] * rstd * g0[e] + b0[e]; v[j][4 + e] = v[j][4 + e] * rstd * g1[e] + b1[e]; } }
}
__device__ __forceinline__ u32x4 pack8(const float* v) { u32x4 w; w.x = cvt_pk_bf16(v[0], v[1]); w.y = cvt_pk_bf16(v[2], v[3]); w.z = cvt_pk_bf16(v[4], v[5]); w.w = cvt_pk_bf16(v[6], v[7]); return w; }
__device__ __forceinline__ void ln_in_row(const float* src, bf16_t* dstb, const float* __restrict__ gam, const float* __restrict__ bet, int lane) {
    float v[4][8];
#pragma unroll
    for (int j = 0; j < 4; ++j) { const f32x4 a0 = __builtin_nontemporal_load((const f32x4*)src + 2 * (lane + 64 * j)), a1 = __builtin_nontemporal_load((const f32x4*)src + 2 * (lane + 64 * j) + 1);
#pragma unroll
        for (int e = 0; e < 4; ++e) { v[j][e] = a0[e]; v[j][4 + e] = a1[e]; } }
    ln_core(v, gam, bet, lane);
#pragma unroll
    for (int j = 0; j < 4; ++j) ((u32x4*)dstb)[lane + 64 * j] = pack8(v[j]);
}
__device__ __forceinline__ void ln_res16_row(bf16_t* xrow, const bf16_t* yrow, const float* __restrict__ gam, const float* __restrict__ bet, int lane) {
    float v[4][8]; u32x4 xw[4], yw[4];
#pragma unroll
    for (int j = 0; j < 4; ++j) { xw[j] = __builtin_nontemporal_load((const u32x4*)xrow + lane + 64 * j); yw[j] = __builtin_nontemporal_load((const u32x4*)yrow + lane + 64 * j); }
#pragma unroll
    for (int j = 0; j < 4; ++j) { float xv[8], yv[8]; unpack8(xw[j], xv); unpack8(yw[j], yv);
#pragma unroll
        for (int e = 0; e < 8; ++e) v[j][e] = xv[e] * ALPHA + yv[e]; }
    ln_core(v, gam, bet, lane);
#pragma unroll
    for (int j = 0; j < 4; ++j) ((u32x4*)xrow)[lane + 64 * j] = pack8(v[j]);
}
__device__ __forceinline__ void ln_res_final16_row(const bf16_t* xrow, const bf16_t* yrow, float* orow, const float* __restrict__ gam, const float* __restrict__ bet, int lane) {
    float v[4][8]; u32x4 xw[4], yw[4];
#pragma unroll
    for (int j = 0; j < 4; ++j) { xw[j] = __builtin_nontemporal_load((const u32x4*)xrow + lane + 64 * j); yw[j] = __builtin_nontemporal_load((const u32x4*)yrow + lane + 64 * j); }
#pragma unroll
    for (int j = 0; j < 4; ++j) { float xv[8], yv[8]; unpack8(xw[j], xv); unpack8(yw[j], yv);
#pragma unroll
        for (int e = 0; e < 8; ++e) v[j][e] = xv[e] * ALPHA + yv[e]; }
    ln_core(v, gam, bet, lane);
#pragma unroll
    for (int j = 0; j < 4; ++j) { f32x4 o0, o1;
#pragma unroll
        for (int e = 0; e < 4; ++e) { o0[e] = v[j][e]; o1[e] = v[j][4 + e]; }
        ((f32x4*)orow)[2 * (lane + 64 * j)] = o0; ((f32x4*)orow)[2 * (lane + 64 * j) + 1] = o1; }
}

__device__ __forceinline__ void attn_phase(LAS unsigned char* lds, bf16_t* B1, const float* __restrict__ rpb, int chunk, int vcu, int G, int tid, int ooff) {
    const int wave = __builtin_amdgcn_readfirstlane(tid >> 6), lane = tid & 63, l15 = lane & 15, g = lane >> 4;
    const int hsel = wave >> 2, cgp = wave & 3;
    const int kapg = 8 * (g & 1) + 4 * (g >> 1); const int kap15 = 8 * ((l15 >> 2) & 1) + 4 * (l15 >> 3) + (l15 & 3);
    const int rows = chunk ? 128 : 256;
    const int nunits = 1024, per = (nunits + G - 1) / G;
    const int sp = (cgp == 0) ? 0 : (cgp == 1) ? 8 : (cgp == 2) ? 24 : 32;
    const int c = 16 * cgp + l15; const int cs = min(max(c - 8, 0), 48);
    const float scale = 0.08838834764831845f;
    LAS float* btab = (LAS float*)(lds + 131072);
    for (int i = tid; i < 8 * 465; i += 512) btab[i] = rpb[i];
    __syncthreads();
    for (int ui = 0; ui < per; ++ui) {
        const int unit = vcu * per + ui; if (unit >= nunits) break;
        const int hp = unit & 3, rowid = unit >> 2, seq = rowid / rows, r = rowid % rows;
        const int h = 2 * hp + hsel;
        const int rs = min(max(r - 4, 0), rows - 8);
        const size_t seqbase = (size_t)seq * rows * 64;
        const bf16_t* qp = B1 + (seqbase + (size_t)r * 64 + c) * B1_LD + Q_OFF + h * 128 + 8 * g;
        bf16x8 qf[4];
#pragma unroll
        for (int s = 0; s < 4; ++s) qf[s] = *(const bf16x8*)(qp + 32 * s);
        f32x4 sacc[16];
#pragma unroll
        for (int kb = 0; kb < 16; ++kb) { const int ir = kb >> 1, hh = kb & 1;
            const bf16_t* kp = B1 + (seqbase + (size_t)(rs + ir) * 64 + sp + 16 * hh + kap15) * B1_LD + K_OFF + h * 128 + 8 * g;
            bf16x8 kf[4];
#pragma unroll
            for (int s = 0; s < 4; ++s) kf[s] = *(const bf16x8*)(kp + 32 * s);
            f32x4 ac = (f32x4){0.f, 0.f, 0.f, 0.f};
#pragma unroll
            for (int s = 0; s < 4; ++s) ac = __builtin_amdgcn_mfma_f32_16x16x32_bf16(kf[s], qf[s], ac, 0, 0, 0);
            sacc[kb] = ac; }
        const LAS float* tb = btab + h * 465;
        float mx = -1e30f;
#pragma unroll
        for (int kb = 0; kb < 16; ++kb) { const int ir = kb >> 1, hh = kb & 1;
#pragma unroll
            for (int i = 0; i < 4; ++i) { const int kc = sp + 16 * hh + kapg + i; const bool valid = (kc >= cs) && (kc < cs + 16);
                int bidx = (rs + ir - r + 7) * 31 + (kc - c + 15); bidx = valid ? bidx : 0;
                const float bias = tb[bidx]; const float sv = valid ? sacc[kb][i] * scale + bias : -1e30f;
                sacc[kb][i] = sv; mx = fmaxf(mx, sv); } }
        mx = fmaxf(mx, __shfl_xor(mx, 16)); mx = fmaxf(mx, __shfl_xor(mx, 32));
        float sum = 0.f;
#pragma unroll
        for (int kb = 0; kb < 16; ++kb)
#pragma unroll
            for (int i = 0; i < 4; ++i) { const float p = __expf(sacc[kb][i] - mx); sum += p; sacc[kb][i] = p; }
        sum += __shfl_xor(sum, 16); sum += __shfl_xor(sum, 32);
        const float inv = 1.0f / sum;
        bf16x8 pf[8];
#pragma unroll
        for (int ks = 0; ks < 8; ++ks) { u32x4 w; w.x = cvt_pk_bf16(sacc[2 * ks][0], sacc[2 * ks][1]); w.y = cvt_pk_bf16(sacc[2 * ks][2], sacc[2 * ks][3]);
            w.z = cvt_pk_bf16(sacc[2 * ks + 1][0], sacc[2 * ks + 1][1]); w.w = cvt_pk_bf16(sacc[2 * ks + 1][2], sacc[2 * ks + 1][3]); pf[ks] = __builtin_bit_cast(bf16x8, w); }
        f32x4 oacc[8];
#pragma unroll
        for (int nb = 0; nb < 8; ++nb) oacc[nb] = (f32x4){0.f, 0.f, 0.f, 0.f};
        const int q4 = l15 >> 2, p4 = l15 & 3;
#pragma unroll
        for (int pass = 0; pass < 2; ++pass) {
            __syncthreads();
#pragma unroll
            for (int b8 = 0; b8 < 2; ++b8) { u32x4 tmp[8];
#pragma unroll
                for (int it = 0; it < 8; ++it) { const int cidx = (b8 * 8 + it) * 512 + tid; const int tk = cidx >> 5, hs = (cidx >> 4) & 1, ch = cidx & 15;
                    tmp[it] = *(const u32x4*)(B1 + (seqbase + (size_t)(rs + 4 * pass) * 64 + tk) * B1_LD + V_OFF + (2 * hp + hs) * 128 + ch * 8); }
#pragma unroll
                for (int it = 0; it < 8; ++it) { const int cidx = (b8 * 8 + it) * 512 + tid; const int tk = cidx >> 5, hs = (cidx >> 4) & 1, ch = cidx & 15;
                    *(LAS u32x4*)(lds + hs * 65536 + 256 * tk + 16 * (ch ^ swz16(tk))) = tmp[it]; } }
            __syncthreads();
            const LAS unsigned char* vb = lds + hsel * 65536;
#pragma unroll
            for (int ksl = 0; ksl < 4; ++ksl) {
                const int row1 = ksl * 64 + sp + kapg + q4, row2 = row1 + 16;
#pragma unroll
                for (int nb = 0; nb < 8; ++nb) { const int ch = 2 * nb + (p4 >> 1);
                    const s16x4 t1 = vtr(vb + 256 * row1 + 16 * (ch ^ swz16(row1)) + 8 * (p4 & 1));
                    const s16x4 t2 = vtr(vb + 256 * row2 + 16 * (ch ^ swz16(row2)) + 8 * (p4 & 1));
                    oacc[nb] = __builtin_amdgcn_mfma_f32_16x16x32_bf16(cat8(t1, t2), pf[pass * 4 + ksl], oacc[nb], 0, 0, 0); } }
        }
        bf16_t* op = B1 + (seqbase + (size_t)r * 64 + c) * B1_LD + ooff + h * 128 + 4 * g;
#pragma unroll
        for (int nb = 0; nb < 8; ++nb) { u32x2 w; w.x = cvt_pk_bf16(oacc[nb][0] * inv, oacc[nb][1] * inv); w.y = cvt_pk_bf16(oacc[nb][2] * inv, oacc[nb][3] * inv); *(u32x2*)(op + 16 * nb) = w; }
    }
    __syncthreads();
}

__device__ __forceinline__ int f_off(int row, int ch) { return 512 * row + 16 * (ch ^ swz16(row)); }

__device__ __forceinline__ void four1_phase(LAS unsigned char* lds, const bf16_t* B1, bf16_t* Z, int chunk, int vcu, int G, int tid) {
    const int wave = __builtin_amdgcn_readfirstlane(tid >> 6), lane = tid & 63, l15 = lane & 15, g = lane >> 4, q4 = l15 >> 2, p4 = l15 & 3;
    const int N2 = chunk ? 64 : 128, nseq = chunk ? 2 : 1, T = 128 * N2;
    const int nunits = nseq * N2 * 4, per = (nunits + G - 1) / G;
    const int k1 = 16 * wave + l15;
    bf16x8 Fc[4], Fs[4];
#pragma unroll
    for (int s = 0; s < 4; ++s) { unsigned wc_[4], ws_[4];
#pragma unroll
        for (int jj = 0; jj < 4; ++jj) { float c0, s0, c1, s1; const int t1a = 32 * s + 8 * g + 2 * jj, t1b = t1a + 1;
            sincospif((float)((k1 * t1a) & 127) * (1.0f / 64.0f), &s0, &c0); sincospif((float)((k1 * t1b) & 127) * (1.0f / 64.0f), &s1, &c1);
            const float sc = 0.08838834764831845f;
            wc_[jj] = cvt_pk_bf16(c0 * sc, c1 * sc); ws_[jj] = cvt_pk_bf16(s0 * sc, s1 * sc); }
        Fc[s] = __builtin_bit_cast(bf16x8, (u32x4){wc_[0], wc_[1], wc_[2], wc_[3]}); Fs[s] = __builtin_bit_cast(bf16x8, (u32x4){ws_[0], ws_[1], ws_[2], ws_[3]}); }
    const int trow0 = tid >> 5, tch = tid & 31;
    u32x4 treg[8];
    if (vcu * per < nunits) { const int unit = vcu * per; const int gq = unit & 3, rest = unit >> 2, t2 = rest % N2, seq = rest / N2;
        const bf16_t* tb = B1 + ((size_t)seq * T + (size_t)trow0 * N2 + t2) * B1_LD + VR_OFF + gq * 256 + tch * 8;
#pragma unroll
        for (int it = 0; it < 8; ++it) treg[it] = __builtin_nontemporal_load((const u32x4*)(tb + (size_t)it * 16 * N2 * B1_LD)); }
    for (int ui = 0; ui < per; ++ui) {
        const int unit = vcu * per + ui; if (unit >= nunits) break;
        const int gq = unit & 3, rest = unit >> 2, t2 = rest % N2, seq = rest / N2;
        const size_t seqbase = (size_t)seq * T;
        __syncthreads();
#pragma unroll
        for (int it = 0; it < 8; ++it) *(LAS u32x4*)(lds + f_off(16 * it + trow0, tch)) = treg[it];
        if (ui + 1 < per && unit + 1 < nunits) { const int un = unit + 1; const int gqn = un & 3, restn = un >> 2, t2n = restn % N2, seqn = restn / N2;
            const bf16_t* tb = B1 + ((size_t)seqn * T + (size_t)trow0 * N2 + t2n) * B1_LD + VR_OFF + gqn * 256 + tch * 8;
#pragma unroll
            for (int it = 0; it < 8; ++it) treg[it] = __builtin_nontemporal_load((const u32x4*)(tb + (size_t)it * 16 * N2 * B1_LD)); }
        __syncthreads();
        float cph, sph; sincospif((float)(k1 * t2) * (2.0f / (float)T), &sph, &cph);
        bf16_t* zrow = Z + (seqbase + (size_t)k1 * N2 + t2) * Z_LD + gq * 512 + 8 * g;
#pragma unroll 2
        for (int nb = 0; nb < 16; ++nb) {
            f32x4 ac = (f32x4){0.f, 0.f, 0.f, 0.f}, as = (f32x4){0.f, 0.f, 0.f, 0.f};
#pragma unroll
            for (int s = 0; s < 4; ++s) { const int r1 = 32 * s + 8 * g + q4, r2 = r1 + 4, ch = 2 * nb + (p4 >> 1);
                const bf16x8 af = cat8(vtr(lds + f_off(r1, ch) + 8 * (p4 & 1)), vtr(lds + f_off(r2, ch) + 8 * (p4 & 1)));
                ac = __builtin_amdgcn_mfma_f32_16x16x32_bf16(af, Fc[s], ac, 0, 0, 0); as = __builtin_amdgcn_mfma_f32_16x16x32_bf16(af, Fs[s], as, 0, 0, 0); }
            u32x4 w;
            w.x = cvt_pk_bf16(ac[0] * cph - as[0] * sph, -as[0] * cph - ac[0] * sph); w.y = cvt_pk_bf16(ac[1] * cph - as[1] * sph, -as[1] * cph - ac[1] * sph);
            w.z = cvt_pk_bf16(ac[2] * cph - as[2] * sph, -as[2] * cph - ac[2] * sph); w.w = cvt_pk_bf16(ac[3] * cph - as[3] * sph, -as[3] * cph - ac[3] * sph);
            *(u32x4*)(zrow + 32 * nb) = w; }
    }
    __syncthreads();
}

__device__ __forceinline__ void four2_phase(LAS unsigned char* lds, const bf16_t* Z, bf16_t* B1, int chunk, int vcu, int G, int tid) {
    const int wave = __builtin_amdgcn_readfirstlane(tid >> 6), lane = tid & 63, l15 = lane & 15, g = lane >> 4, q4 = l15 >> 2, p4 = l15 & 3;
    const int N2 = chunk ? 64 : 128, nseq = chunk ? 2 : 1, T = 128 * N2;
    const int nunits = nseq * 128 * 8, per = (nunits + G - 1) / G;
    const int nkb = N2 >> 4, kb = wave % nkb, npart = wave / nkb, nbn = 16 / (8 / nkb), nsteps = N2 >> 5;
    const int k2 = 16 * kb + l15;
    const float sc = chunk ? 0.125f : 0.08838834764831845f; const float angs = 2.0f / (float)N2;
    bf16x8 Fc[4], Fs[4];
#pragma unroll
    for (int s = 0; s < 4; ++s) { unsigned wc_[4], ws_[4];
#pragma unroll
        for (int jj = 0; jj < 4; ++jj) { float c0, s0, c1, s1; const int ta = 32 * s + 8 * g + 2 * jj, tb = ta + 1;
            sincospif((float)((k2 * ta) & (N2 - 1)) * angs, &s0, &c0); sincospif((float)((k2 * tb) & (N2 - 1)) * angs, &s1, &c1);
            wc_[jj] = cvt_pk_bf16(c0 * sc, c1 * sc); ws_[jj] = cvt_pk_bf16(s0 * sc, s1 * sc); }
        Fc[s] = __builtin_bit_cast(bf16x8, (u32x4){wc_[0], wc_[1], wc_[2], wc_[3]}); Fs[s] = __builtin_bit_cast(bf16x8, (u32x4){ws_[0], ws_[1], ws_[2], ws_[3]}); }
    const int nchunks = N2 * 32 / 512;
    const int trow0 = tid >> 5, tch = tid & 31;
    u32x4 treg[8];
    if (vcu * per < nunits) { const int unit = vcu * per; const int cb = unit & 7, rest = unit >> 3, k1 = rest & 127, seq = rest >> 7;
        const bf16_t* tb = Z + ((size_t)seq * T + (size_t)k1 * N2 + trow0) * Z_LD + cb * 256 + tch * 8;
#pragma unroll
        for (int it = 0; it < 8; ++it) if (it < nchunks) treg[it] = __builtin_nontemporal_load((const u32x4*)(tb + (size_t)it * 16 * Z_LD)); }
    for (int ui = 0; ui < per; ++ui) {
        const int unit = vcu * per + ui; if (unit >= nunits) break;
        const int cb = unit & 7, rest = unit >> 3, k1 = rest & 127, seq = rest >> 7;
        const size_t seqbase = (size_t)seq * T;
        __syncthreads();
#pragma unroll
        for (int it = 0; it < 8; ++it) if (it < nchunks) *(LAS u32x4*)(lds + f_off(16 * it + trow0, tch)) = treg[it];
        if (ui + 1 < per && unit + 1 < nunits) { const int un = unit + 1; const int cbn = un & 7, restn = un >> 3, k1n = restn & 127, seqn = restn >> 7;
            const bf16_t* tb = Z + ((size_t)seqn * T + (size_t)k1n * N2 + trow0) * Z_LD + cbn * 256 + tch * 8;
#pragma unroll
            for (int it = 0; it < 8; ++it) if (it < nchunks) treg[it] = __builtin_nontemporal_load((const u32x4*)(tb + (size_t)it * 16 * Z_LD)); }
        __syncthreads();
        bf16_t* orow = B1 + (seqbase + (size_t)k1 + 128 * (size_t)k2) * B1_LD + cb * 128 + 2 * g;
        for (int nbi = 0; nbi < nbn; ++nbi) { const int nb = npart * nbn + nbi;
            f32x4 pc = (f32x4){0.f, 0.f, 0.f, 0.f}, ps = (f32x4){0.f, 0.f, 0.f, 0.f};
#pragma unroll
            for (int s = 0; s < 4; ++s) { if (s < nsteps) { const int r1 = 32 * s + 8 * g + q4, r2 = r1 + 4, ch = 2 * nb + (p4 >> 1);
                const bf16x8 af = cat8(vtr(lds + f_off(r1, ch) + 8 * (p4 & 1)), vtr(lds + f_off(r2, ch) + 8 * (p4 & 1)));
                pc = __builtin_amdgcn_mfma_f32_16x16x32_bf16(af, Fc[s], pc, 0, 0, 0); ps = __builtin_amdgcn_mfma_f32_16x16x32_bf16(af, Fs[s], ps, 0, 0, 0); } }
            const unsigned vr = cvt_pk_bf16(pc[0] + ps[1], pc[2] + ps[3]), vi = cvt_pk_bf16(pc[1] - ps[0], pc[3] - ps[2]);
            *(unsigned*)(orow + VR_OFF + 8 * nb) = vr; *(unsigned*)(orow + VI_OFF + 8 * nb) = vi; }
    }
    __syncthreads();
}


#define XB_TMO      128
#define XB_XCNT(j)  (256  + 64 * (j))
#define XB_XSUB(j)  (1280 + 64 * (j))
#define XB_XGEN(j)  (2304 + 64 * (j))
#define XB_TOP      3328
#define XB_TOPGEN   3392
#define XCD_BAR_WORDS 3456
#define XB_SPIN_CAP (1u << 18)
__device__ __forceinline__ unsigned xb_ld(unsigned* p)              { return __hip_atomic_load(p, __ATOMIC_RELAXED, __HIP_MEMORY_SCOPE_AGENT); }
__device__ __forceinline__ unsigned xb_add(unsigned* p, unsigned v) { return __hip_atomic_fetch_add(p, v, __ATOMIC_RELAXED, __HIP_MEMORY_SCOPE_AGENT); }
__device__ __forceinline__ unsigned xb_xcc_id() { return (unsigned)__builtin_amdgcn_s_getreg((3 << 11) | 20) & 0xFu; }
#define XB_SPIN(cond, bar) do { unsigned _sp = 0; while (cond) { __builtin_amdgcn_s_sleep(1); \
    if ((++_sp & 255u) == 0u) { if (xb_ld(&(bar)[XB_TMO])) break; if (_sp > XB_SPIN_CAP) { atomicAdd(&(bar)[XB_TMO], 1u); break; } } } } while (0)
struct XcdBarrier { unsigned* bar; unsigned x; volatile LAS unsigned* st; };
__device__ __forceinline__ XcdBarrier xcd_barrier_post(unsigned* bar, volatile LAS unsigned* st) {
    XcdBarrier b; b.bar = bar; b.x = xb_xcc_id(); b.st = st;
    if (threadIdx.x == 0) (void)xb_add(&bar[XB_XCNT(b.x)], 1u);
    return b;
}
__device__ __forceinline__ void xcd_barrier_complete(unsigned* bar, unsigned x, unsigned& nloc, unsigned& nx) {
    const unsigned G = gridDim.x * gridDim.y * gridDim.z;
    unsigned sum, cnt, mine, sp = 0u;
    for (;;) {
        sum = 0u; cnt = 0u; mine = 0u;
#pragma unroll
        for (unsigned j = 0; j < 16; ++j) { const unsigned c = xb_ld(&bar[XB_XCNT(j)]); sum += c; cnt += (c > 0u) ? 1u : 0u; mine = (j == x) ? c : mine; }
        if (sum == G) break;
        __builtin_amdgcn_s_sleep(1);
        if ((++sp & 255u) == 0u) { if (xb_ld(&bar[XB_TMO])) break; if (sp > XB_SPIN_CAP) { atomicAdd(&bar[XB_TMO], 1u); break; } }
    }
    nloc = mine > 0u ? mine : 1u; nx = cnt > 0u ? cnt : 1u;
}
__device__ __forceinline__ void xcd_barrier(const XcdBarrier& b) {
    asm volatile("s_waitcnt vmcnt(0)" ::: "memory");
    __syncthreads();
    if (threadIdx.x == 0) {
        unsigned* bar = b.bar;
        __builtin_amdgcn_s_waitcnt(0);
        unsigned nloc = b.st[0], nx = b.st[1];
        if (nloc == 0u) { xcd_barrier_complete(bar, b.x, nloc, nx); b.st[0] = nloc; b.st[1] = nx; }
        const unsigned old = xb_add(&bar[XB_XSUB(b.x)], 1u);
        const unsigned gen = old / nloc;
        if (old + 1u == (gen + 1u) * nloc) {
            __builtin_amdgcn_fence(__ATOMIC_RELEASE, "agent");
            asm volatile("s_waitcnt vmcnt(0)" ::: "memory");
            const unsigned og = xb_add(&bar[XB_TOP], 1u);
            const unsigned tg = og / nx;
            if (og + 1u == (tg + 1u) * nx) xb_add(&bar[XB_TOPGEN], 1u);
            else XB_SPIN(xb_ld(&bar[XB_TOPGEN]) == tg, bar);
            __builtin_amdgcn_fence(__ATOMIC_ACQUIRE, "agent");
            xb_add(&bar[XB_XGEN(b.x)], 1u);
            asm volatile("s_waitcnt vmcnt(0)" ::: "memory");
        } else {
            XB_SPIN(xb_ld(&bar[XB_XGEN(b.x)]) == gen, bar);
            __builtin_amdgcn_fence(__ATOMIC_ACQUIRE, "agent");
            asm volatile("s_waitcnt vmcnt(0)" ::: "memory");
        }
    }
    __syncthreads();
}

enum { K_P1 = 0, K_ATT = 1, K_F2 = 2, K_P3 = 3, K_P4 = 4, K_LN1 = 5, K_P5 = 6, K_P6 = 7, K_LN2 = 8 };
constexpr int PH_PER_LAYER = 13, N_PHASES = 1 + DEPTH * PH_PER_LAYER;

__global__ void __launch_bounds__(512, 2) fwd_mega(Args a) {
    extern __shared__ __attribute__((aligned(16))) unsigned char lds_raw[];
    LAS unsigned char* lds = (LAS unsigned char*)lds_raw;
    cg::grid_group grid = cg::this_grid();
    const int G0 = gridDim.x, bx0 = blockIdx.x;
    unsigned char* ws = a.ws;
    bf16_t* Bt1 = (bf16_t*)(ws + WS_BT1); bf16_t* Bt3 = (bf16_t*)(ws + WS_BT3); bf16_t* WfT = (bf16_t*)(ws + WS_WFT); bf16_t* Bt4 = (bf16_t*)(ws + WS_BT4);
    bf16_t* Bt5 = (bf16_t*)(ws + WS_BT5); bf16_t* Bt6 = (bf16_t*)(ws + WS_BT6); bf16_t* Tab = (bf16_t*)(ws + WS_TAB);
    bf16_t* XB = (bf16_t*)(ws + WS_XB); bf16_t* B1 = (bf16_t*)(ws + WS_B1); bf16_t* Gt = (bf16_t*)(ws + WS_G); bf16_t* Z = (bf16_t*)(ws + WS_Z); bf16_t* Hb = (bf16_t*)(ws + WS_H);
    bf16_t* YLA = (bf16_t*)(ws + WS_BT1); bf16_t* YLB = (bf16_t*)(ws + WS_YB);
    float* X = a.out; bf16_t* Y16 = (bf16_t*)a.out; bf16_t* MbAll = (bf16_t*)a.out + (size_t)TALL * DM;
    volatile LAS unsigned* bst = (volatile LAS unsigned*)(lds + 147440);
    if (threadIdx.x < 2) bst[threadIdx.x] = 0u;
    __syncthreads();
    const XcdBarrier xbar = xcd_barrier_post((unsigned*)(ws + WS_CTL), bst);

    for (int ph = a.ph_lo; ph < a.ph_hi; ++ph) {
        int tid = threadIdx.x; asm volatile("" : "+v"(tid));
        int G = G0, bx = bx0; asm volatile("" : "+s"(G), "+s"(bx));
        const int vcu = (G % 8 == 0) ? (bx % 8) * (G / 8) + bx / 8 : bx; const int NGW = G * 8;
        const int lane = tid & 63, wave = __builtin_amdgcn_readfirstlane(tid >> 6), gw = vcu * 8 + wave;
        if (ph == 0) {
            wphase(a, 0, lds, gw, NGW, wave, lane);
            for (int m = gw; m < TALL; m += NGW) { const float* src = (m < CHT) ? a.in[0] + (size_t)m * DM : a.in[1] + (size_t)(m - CHT) * DM;
                ln_in_row(src, XB + (size_t)m * DM, a.in[2], a.in[3], lane); }
        } else {
            const int layer = (ph - 1) / PH_PER_LAYER, r = (ph - 1) % PH_PER_LAYER;
            const int chunk = (r < 8) ? r / 4 : 0, kind = (r < 8) ? r % 4 : r - 4;
            if (kind == K_P1) {
                { pg8::Gemm gm{XB + (size_t)chunk * CHT * DM, Bt1, DM, DM, DM}; pg8::StaticOrder S; S.init(CHT, 8192, G, bx);
                  pg8::EpiP1 E{B1, Gt, a.in[9] + (size_t)layer * 4096};
                  pg8::gemm_phase<pg8::EpiP1>(lds, gm, S, E, tid); }
                if (chunk == 0) { pg8::Gemm gm{WfT, Tab, 256, 256, 256}; pg8::StaticOrder S; S.init(8192, 512, G, bx);
                  pg8::EpiFold E{Bt3};
                  pg8::gemm_phase<pg8::EpiFold>(lds, gm, S, E, tid); }
            } else if (kind == K_ATT) {
                attn_phase(lds, B1, a.in[5] + (size_t)layer * 8 * 465, chunk, vcu, G, tid, Q_OFF);
                four1_phase(lds, B1, Z, chunk, vcu, G, tid);
            } else if (kind == K_F2) {
                four2_phase(lds, Z, B1, chunk, vcu, G, tid);
            } else if (kind == K_P3) {
                pg8::Gemm gm{B1, Bt3, B1_LD, 3072, 3072}; pg8::StaticOrder S; S.init(CHT, DM, G, bx);
                pg8::EpiP3 E{Gt, MbAll + (size_t)chunk * CHT * DM};
                pg8::gemm_phase<pg8::EpiP3>(lds, gm, S, E, tid);
            } else if (kind == K_P4) {
                pg8::Gemm gm{MbAll, Bt4, MB_LD, DM, DM}; pg8::StaticOrder S; S.init(TALL, DM, G, bx);
                pg8::EpiY E{Y16, Y16, 1 << 30};
                pg8::gemm_phase<pg8::EpiY>(lds, gm, S, E, tid);
            } else if (kind == K_LN1) {
                const float* gam = a.in[11] + (size_t)layer * DM; const float* bet = a.in[12] + (size_t)layer * DM;
                for (int m = gw; m < TALL; m += NGW) ln_res16_row(XB + (size_t)m * DM, Y16 + (size_t)m * DM, gam, bet, lane);
            } else if (kind == K_P5) {
                pg8::Gemm gm{XB, Bt5, DM, DM, DM}; pg8::StaticOrder S; S.init(TALL, 2 * DFF, G, bx);
                pg8::EpiSwiglu E{Hb};
                pg8::gemm_phase<pg8::EpiSwiglu>(lds, gm, S, E, tid);
            } else if (kind == K_P6) {
                pg8::Gemm gm{Hb, Bt6, H_LD, DFF, DFF}; pg8::StaticOrder S; S.init(TALL, DM, G, bx);
                const pg8::EpiY E = (layer + 1 < DEPTH) ? pg8::EpiY{Y16, Y16, 1 << 30} : pg8::EpiY{YLA, YLB - (size_t)25600 * DM, 100};
                pg8::gemm_phase<pg8::EpiY>(lds, gm, S, E, tid);
            } else {
                const float* gam = a.in[16] + (size_t)layer * DM; const float* bet = a.in[17] + (size_t)layer * DM;
                if (layer + 1 < DEPTH) { for (int m = gw; m < TALL; m += NGW) ln_res16_row(XB + (size_t)m * DM, Y16 + (size_t)m * DM, gam, bet, lane); }
                else { for (int m = gw; m < TALL; m += NGW) ln_res_final16_row(XB + (size_t)m * DM, (m < 25600 ? YLA : YLB - (size_t)25600 * DM) + (size_t)m * DM, X + (size_t)m * DM, gam, bet, lane); }
                if (layer + 1 < DEPTH) wphase(a, layer + 1, lds, gw, NGW, wave, lane);
            }
        }
        if (ph + 1 < a.ph_hi) {
            if (a.ph_hi > (1 << 20)) grid.sync();
            xcd_barrier(xbar);
        }
    }
}

extern "C" void kernel_launch(void* const* d_in, const int* in_sizes, int n_in, void* d_out, int out_size, void* d_ws, size_t ws_size, hipStream_t stream) {
    static int grid = 0;
    if (grid == 0) {
        if (n_in != 18 || out_size != TALL * DM || ws_size < WS_END) { fprintf(stderr, "kernel_launch: unexpected shapes (n_in %d out %d ws %zu, need ws >= %zu)\n", n_in, out_size, ws_size, (size_t)WS_END); grid = -1; return; }
        int dev = 0, cus = 0, per_cu = 0;
        hipGetDevice(&dev); hipDeviceGetAttribute(&cus, hipDeviceAttributeMultiprocessorCount, dev);
        if (hipFuncSetAttribute((const void*)fwd_mega, hipFuncAttributeMaxDynamicSharedMemorySize, LDS_BYTES) != hipSuccess) { fprintf(stderr, "kernel_launch: hipFuncSetAttribute failed\n"); grid = -1; return; }
        if (hipOccupancyMaxActiveBlocksPerMultiprocessor(&per_cu, (const void*)fwd_mega, 512, LDS_BYTES) != hipSuccess || per_cu < 1) { fprintf(stderr, "kernel_launch: occupancy query says %d\n", per_cu); per_cu = 1; }
        (void)hipGetLastError();
        grid = cus * 1;
    }
    if (grid < 0) return;
    if (hipMemsetAsync((char*)d_ws + WS_CTL, 0, 65536, stream) != hipSuccess) { fprintf(stderr, "kernel_launch: memset failed\n"); return; }
    Args a{};
    for (int i = 0; i < 18; ++i) a.in[i] = (const float*)d_in[i];
    a.out = (float*)d_out; a.ws = (unsigned char*)d_ws;
#if MK_PER_PHASE
    for (int ph = 0; ph < N_PHASES; ++ph) { a.ph_lo = ph; a.ph_hi = ph + 1; hipLaunchKernelGGL(fwd_mega, dim3(grid), dim3(512), LDS_BYTES, stream, a); }
#else
    a.ph_lo = 0; a.ph_hi = N_PHASES;
    void* args[] = {&a};
    hipError_t e = hipLaunchCooperativeKernel((const void*)fwd_mega, dim3(grid), dim3(512), args, LDS_BYTES, stream);
    if (e != hipSuccess) fprintf(stderr, "cooperative launch failed: %s (grid %d)\n", hipGetErrorString(e), grid);
#endif
}
```
